# Optimizing an MI355X kernel written in HIP

```python
import jax, jax.numpy as jnp
from jax import lax
import numpy as np

D_MODEL = 1024
BATCH = 32
SEQ = 256
DEPTH = 2
DEC_BATCH = 8
DEC_SEQ = 2048
PAST_LEN = 512

GRID_W = 64
CHUNK = 128
Q_BLOCK = 128
A_WIDTH = D_MODEL // 2
A_GROUPS = 4
A_GC = A_WIDTH // A_GROUPS
HEAD_DIM = 64
N_Q = (D_MODEL // 2) // HEAD_DIM
N_KV = N_Q // 4
GQA = N_Q // N_KV
Q_W = N_Q * HEAD_DIM
KV_W = N_KV * HEAD_DIM
ROPE_THETA = 10000.0
C_HEAD = 64
C_WIDTH = D_MODEL // 2
C_HEADS = C_WIDTH // C_HEAD
DECAY_LORA = 64
AAA_LORA = 64
GATE_LORA = 128
N_DIR = 2
RWKV_FEAT = 3 * C_WIDTH + DECAY_LORA + AAA_LORA
GN_EPS = 64e-5
N_BRANCH = 3
D_FF = 4 * D_MODEL
ALPHA = (2 * DEPTH) ** 0.25
BETA = (8 * DEPTH) ** -0.25
IN_SIZES = (A_WIDTH, A_WIDTH, Q_W, KV_W, KV_W, 3 * C_WIDTH, N_DIR * (DECAY_LORA + AAA_LORA), GATE_LORA, N_BRANCH * D_MODEL)
IN_COLS = A_WIDTH * 2 + Q_W + 2 * KV_W + 3 * C_WIDTH + N_DIR * (DECAY_LORA + AAA_LORA) + GATE_LORA + N_BRANCH * D_MODEL

kernel_name = 'hybrid_diffusion_gmlp_gqa_rwkv7_step'


def _split_cols(x, sizes):
    out, start = [], 0
    for s in sizes:
        out.append(x[..., start:start + s])
        start += s
    return out


def _layer_norm(x, g, b, eps=1e-5):
    xf = x.astype(jnp.float32)
    mu = jnp.mean(xf, -1, keepdims=True)
    var = jnp.mean(jnp.square(xf - mu), -1, keepdims=True)
    return ((xf - mu) * lax.rsqrt(var + eps)).astype(x.dtype) * g + b


def _rms_norm(x, g, eps=1e-6):
    xf = x.astype(jnp.float32)
    return (xf * lax.rsqrt(jnp.mean(xf * xf, -1, keepdims=True) + eps)).astype(x.dtype) * g


def _axial_rope(x):
    L = x.shape[1]
    rows = L // GRID_W
    row = jnp.repeat(jnp.arange(rows, dtype=jnp.float32), GRID_W)
    col = jnp.tile(jnp.arange(GRID_W, dtype=jnp.float32), rows)
    half = HEAD_DIM // 2
    inv_freq = ROPE_THETA ** (-jnp.arange(0, half, 2, dtype=jnp.float32) / half)
    xf = x.astype(jnp.float32)

    def rot(xp, pos):
        ang = pos[:, None] * inv_freq[None, :]
        cos = jnp.cos(ang)[None, :, None, :]
        sin = jnp.sin(ang)[None, :, None, :]
        x1, x2 = xp[..., :half // 2], xp[..., half // 2:]
        return jnp.concatenate([x1 * cos - x2 * sin, x2 * cos + x1 * sin], -1)

    out = jnp.concatenate([rot(xf[..., :half], row), rot(xf[..., half:], col)], -1)
    return out.astype(x.dtype)


def _blocked_attention(q, k, v):
    B, Lq = q.shape[0], q.shape[1]
    nb = Lq // Q_BLOCK
    qb = jnp.moveaxis(q.reshape(B, nb, Q_BLOCK, N_KV, GQA, HEAD_DIM), 1, 0)
    scale = HEAD_DIM ** -0.5

    def one_block(qblk):
        s = jnp.einsum('bqhgd,bkhd->bhgqk', qblk, k).astype(jnp.float32) * scale
        p = jax.nn.softmax(s, axis=-1).astype(v.dtype)
        return jnp.einsum('bhgqk,bkhd->bqhgd', p, v)

    o = lax.map(one_block, qb)
    return jnp.moveaxis(o, 0, 1).reshape(B, Lq, Q_W)


def _chunk_spatial_gate(u, v, ln_g, ln_b, w_s, b_s):
    B, L, _ = u.shape
    vn = _layer_norm(v, ln_g, ln_b).reshape(B, L // CHUNK, CHUNK, A_GROUPS, A_GC)
    s = jnp.einsum('gpq,bnqgc->bnpgc', w_s, vn) + b_s.T[None, None, :, :, None]
    return u * s.reshape(B, L, A_WIDTH)


def _token_shift(f, mu, reverse):
    zero = jnp.zeros_like(f[:, :1])
    nb = jnp.concatenate([f[:, 1:], zero], 1) if reverse else jnp.concatenate([zero, f[:, :-1]], 1)
    return f + mu * (nb - f)


def _wkv_scan(r, w, k, v, a, b, s0, reverse):
    xs = tuple(jnp.moveaxis(t.astype(jnp.float32), 1, 0) for t in (r, w, k, v, a, b))

    def step(S, xt):
        r_t, w_t, k_t, v_t, a_t, b_t = xt
        sa = jnp.einsum('bhvk,bhk->bhv', S, a_t)
        S = S * w_t[:, :, None, :] + sa[..., None] * b_t[:, :, None, :] + v_t[..., None] * k_t[:, :, None, :]
        return S, jnp.einsum('bhvk,bhk->bhv', S, r_t)

    s_fin, ys = lax.scan(step, s0.astype(jnp.float32), xs, reverse=reverse)
    return jnp.moveaxis(ys, 0, 1).astype(r.dtype), s_fin


def _rwkv_mix(rkv, lora, g_down, s0, P, l):
    B, L, _ = rkv.shape
    hs = lambda t: t.reshape(B, L, C_HEADS, C_HEAD)
    k_k = P['rwkv_k_k'][l].reshape(C_HEADS, C_HEAD)
    k_a = P['rwkv_k_a'][l].reshape(C_HEADS, C_HEAD)
    y_sum, bonus_sum, finals = 0.0, 0.0, []
    for d in range(N_DIR):
        f = _token_shift(jnp.concatenate([rkv, lora[:, :, d]], -1), P['rwkv_mu'][l, d], reverse=(d == 1))
        r, k, v, wd, ad = _split_cols(f, (C_WIDTH, C_WIDTH, C_WIDTH, DECAY_LORA, AAA_LORA))
        w_log = (-jax.nn.softplus(-(P['rwkv_w0'][l, d] + jnp.tanh(wd) @ P['rwkv_w2'][l, d])) - 0.5).astype(jnp.float32)
        decay = hs(jnp.exp(-jnp.exp(w_log)))
        a = hs(jax.nn.sigmoid(P['rwkv_a0'][l, d] + ad @ P['rwkv_a2'][l, d]))
        r, k, v = hs(r), hs(k), hs(v)
        kk = k * k_k
        kk = kk / jnp.maximum(jnp.sqrt(jnp.sum(jnp.square(kk.astype(jnp.float32)), -1, keepdims=True)), 1e-12).astype(kk.dtype)
        k_mod = k * (1 + (a - 1) * k_a)
        y, s_fin = _wkv_scan(r, decay, k_mod, v, -kk, kk * a, s0[:, d], reverse=(d == 1))
        y_sum = y_sum + y
        bonus_sum = bonus_sum + jnp.sum(r * k_mod * P['rwkv_r_k'][l], -1, keepdims=True) * v
        finals.append(s_fin)
    yf = y_sum.astype(jnp.float32)
    mu = jnp.mean(yf, -1, keepdims=True)
    var = jnp.mean(jnp.square(yf - mu), -1, keepdims=True)
    gn = ((yf - mu) * lax.rsqrt(var + GN_EPS)).astype(rkv.dtype).reshape(B, L, C_WIDTH)
    gn = gn * P['rwkv_lnx_g'][l] + P['rwkv_lnx_b'][l]
    g = jax.nn.sigmoid(g_down) @ P['rwkv_g2'][l]
    out = (gn + bonus_sum.reshape(B, L, C_WIDTH)) * g
    return out, jnp.stack(finals, axis=1)


def _trunk_layer(x, cvec, P, l, ctx):
    B, L, _ = x.shape
    latent = ctx is not None
    mod = (jax.nn.silu(cvec) @ P['w_ada'][l] + P['b_ada'][l])[:, None, :]
    sh1, sc1, g1, sh2, sc2, g2 = jnp.split(mod, 6, axis=-1)
    h = x * (1 + sc1) + sh1
    proj = h @ P['w_in'][l]
    uA, vA, q, k, v, rkv, lora, g_down, g_log = _split_cols(proj, IN_SIZES)
    oA = _chunk_spatial_gate(uA, vA, P['sgu_ln_g'][l], P['sgu_ln_b'][l], P['sgu_w'][l], P['sgu_b'][l])
    q = _rms_norm(q.reshape(B, L, N_Q, HEAD_DIM), P['q_norm'][l])
    k = _rms_norm(k.reshape(B, L, N_KV, HEAD_DIM), P['k_norm'][l])
    v = v.reshape(B, L, N_KV, HEAD_DIM)
    if latent:
        ctx_k, ctx_v, ctx_s = ctx
        q_r, k_r = _axial_rope(q), _axial_rope(k)
        oB = _blocked_attention(q_r, jnp.concatenate([ctx_k, k_r], 1), jnp.concatenate([ctx_v, v], 1))
        s0 = ctx_s
    else:
        oB = _blocked_attention(q, k, v)
        s0 = jnp.zeros((B, N_DIR, C_HEADS, C_HEAD, C_HEAD), jnp.float32)
    oC, s_fin = _rwkv_mix(rkv, lora.reshape(B, L, N_DIR, DECAY_LORA + AAA_LORA), g_down, s0, P, l)
    branches = jnp.stack([oA, oB, oC], axis=2)
    p = jnp.einsum('bljc,jcd->bljd', branches, P['w_branch'][l])
    gates = jax.nn.sigmoid(g_log.reshape(B, L, N_BRANCH, D_MODEL))
    mixed = jnp.sum(gates * p, axis=2) @ P['w_out'][l]
    x = _layer_norm(ALPHA * x + g1 * mixed, P['ln1_g'][l], P['ln1_b'][l])
    h = x * (1 + sc2) + sh2
    f = jnp.square(jax.nn.relu(h @ P['w_up'][l])) @ P['w_down'][l]
    x = _layer_norm(ALPHA * x + g2 * f, P['ln2_g'][l], P['ln2_b'][l])
    if latent:
        return x
    return x, (k, v, s_fin.astype(x.dtype))


def setup_inputs(seed: int = 0) -> dict:
    key = jax.random.key(seed)
    ks = iter(jax.random.split(key, 48))
    nrm = lambda shape, s=1.0: s * jax.random.normal(next(ks), shape, jnp.float32)
    return {
        'x_prompt': nrm((BATCH, SEQ, D_MODEL)),
        'x_sample': nrm((DEC_BATCH, DEC_SEQ, D_MODEL)),
        'cache_k': nrm((DEC_BATCH, DEPTH, PAST_LEN, N_KV, HEAD_DIM)),
        'cache_v': nrm((DEC_BATCH, DEPTH, PAST_LEN, N_KV, HEAD_DIM)),
        'state_wkv': nrm((DEC_BATCH, DEPTH, N_DIR, C_HEADS, C_HEAD, C_HEAD), 0.5),
        'c': nrm((DEC_BATCH, D_MODEL)),
        'c_ctx': nrm((D_MODEL,)),
        'w_ada': nrm((DEPTH, D_MODEL, 6 * D_MODEL), 0.5 * D_MODEL ** -0.5),
        'b_ada': nrm((DEPTH, 6 * D_MODEL), 0.01),
        'w_in': nrm((DEPTH, D_MODEL, IN_COLS), D_MODEL ** -0.5),
        'sgu_ln_g': 1.0 + nrm((DEPTH, A_WIDTH), 0.02),
        'sgu_ln_b': nrm((DEPTH, A_WIDTH), 0.02),
        'sgu_w': nrm((DEPTH, A_GROUPS, CHUNK, CHUNK), 0.5 * CHUNK ** -0.5),
        'sgu_b': 1.0 + nrm((DEPTH, A_GROUPS, CHUNK), 0.02),
        'q_norm': 1.0 + nrm((DEPTH, HEAD_DIM), 0.02),
        'k_norm': 1.0 + nrm((DEPTH, HEAD_DIM), 0.02),
        'rwkv_mu': jax.random.uniform(next(ks), (DEPTH, N_DIR, RWKV_FEAT), jnp.float32),
        'rwkv_w0': nrm((DEPTH, N_DIR, C_WIDTH), 0.5),
        'rwkv_w2': nrm((DEPTH, N_DIR, DECAY_LORA, C_WIDTH), 0.3 * DECAY_LORA ** -0.5),
        'rwkv_a0': nrm((DEPTH, N_DIR, C_WIDTH), 0.1),
        'rwkv_a2': nrm((DEPTH, N_DIR, AAA_LORA, C_WIDTH), 0.5 * AAA_LORA ** -0.5),
        'rwkv_k_k': 0.85 + nrm((DEPTH, C_WIDTH), 0.02),
        'rwkv_k_a': 1.0 + nrm((DEPTH, C_WIDTH), 0.02),
        'rwkv_r_k': nrm((DEPTH, C_HEADS, C_HEAD), 0.1),
        'rwkv_g2': nrm((DEPTH, GATE_LORA, C_WIDTH), GATE_LORA ** -0.5),
        'rwkv_lnx_g': 1.0 + nrm((DEPTH, C_WIDTH), 0.02),
        'rwkv_lnx_b': nrm((DEPTH, C_WIDTH), 0.02),
        'w_branch': nrm((DEPTH, N_BRANCH, C_WIDTH, D_MODEL), BETA * C_WIDTH ** -0.5),
        'w_out': nrm((DEPTH, D_MODEL, D_MODEL), BETA * D_MODEL ** -0.5),
        'ln1_g': 1.0 + nrm((DEPTH, D_MODEL), 0.02),
        'ln1_b': nrm((DEPTH, D_MODEL), 0.02),
        'w_up': nrm((DEPTH, D_MODEL, D_FF), D_MODEL ** -0.5),
        'w_down': nrm((DEPTH, D_FF, D_MODEL), BETA * D_FF ** -0.5),
        'ln2_g': 1.0 + nrm((DEPTH, D_MODEL), 0.02),
        'ln2_b': nrm((DEPTH, D_MODEL), 0.02),
    }


def reference(x_prompt, x_sample, cache_k, cache_v, state_wkv, c, c_ctx, w_ada, b_ada, w_in, sgu_ln_g, sgu_ln_b, sgu_w, sgu_b, q_norm, k_norm, rwkv_mu, rwkv_w0, rwkv_w2, rwkv_a0, rwkv_a2, rwkv_k_k, rwkv_k_a, rwkv_r_k, rwkv_g2, rwkv_lnx_g, rwkv_lnx_b, w_branch, w_out, ln1_g, ln1_b, w_up, w_down, ln2_g, ln2_b):
    P = dict(w_ada=w_ada, b_ada=b_ada, w_in=w_in, sgu_ln_g=sgu_ln_g, sgu_ln_b=sgu_ln_b, sgu_w=sgu_w, sgu_b=sgu_b,
             q_norm=q_norm, k_norm=k_norm, rwkv_mu=rwkv_mu, rwkv_w0=rwkv_w0, rwkv_w2=rwkv_w2, rwkv_a0=rwkv_a0,
             rwkv_a2=rwkv_a2, rwkv_k_k=rwkv_k_k, rwkv_k_a=rwkv_k_a, rwkv_r_k=rwkv_r_k, rwkv_g2=rwkv_g2,
             rwkv_lnx_g=rwkv_lnx_g, rwkv_lnx_b=rwkv_lnx_b, w_branch=w_branch, w_out=w_out, ln1_g=ln1_g,
             ln1_b=ln1_b, w_up=w_up, w_down=w_down, ln2_g=ln2_g, ln2_b=ln2_b)
    y = x_prompt
    ks, vs, ss = [], [], []
    for l in range(DEPTH):
        y, (k_l, v_l, s_l) = _trunk_layer(y, c_ctx[None, :], P, l, None)
        ks.append(k_l)
        vs.append(v_l)
        ss.append(s_l)
    new_cache_k = jnp.stack(ks, axis=1)
    new_cache_v = jnp.stack(vs, axis=1)
    new_state_wkv = jnp.stack(ss, axis=1)
    z = x_sample
    for l in range(DEPTH):
        z = _trunk_layer(z, c, P, l, (cache_k[:, l], cache_v[:, l], state_wkv[:, l]))
    return (y, z, new_cache_k, new_cache_v, new_state_wkv)
```

```cpp
#include <hip/hip_runtime.h>
#include <hip/hip_cooperative_groups.h>
#include <cstdio>
namespace cg = cooperative_groups;

typedef unsigned short u16;
typedef __attribute__((ext_vector_type(8))) short bf16x8;
typedef __attribute__((ext_vector_type(4))) short bf16x4;
typedef __attribute__((ext_vector_type(4))) float f32x4;

#define DEV __device__ __forceinline__

constexpr int TCTX = 8192, TLAT = 16384, TT = 24576;
constexpr float ALPHA = 1.41421356237309515f;
constexpr float GN_EPS = 64e-5f;
constexpr int NTHR = 256;

constexpr size_t OFF_MOD = 0;
constexpr size_t OFF_COEF = 524288;
constexpr size_t OFF_CTR = 516096;
constexpr size_t OFF_W = 2101248;
constexpr size_t W_UP = 0, W_DOWN = 4194304, W_IN = 8388608, W_BR = 15335424, W_OUT = 16908288,
                 W_SGU = 17956864, W_W2 = 18022400, W_A2 = 18087936, W_G2 = 18153472, W_TOTAL = 18219008;
constexpr size_t OFF_KC = OFF_W + W_TOTAL * 2;
constexpr size_t KC_LAT = 1048576;
constexpr size_t KC_ELEMS = 3670016;
constexpr size_t OFF_VT = OFF_KC + KC_ELEMS * 2;
constexpr size_t OFF_P = OFF_VT + KC_ELEMS * 2;
constexpr size_t F_UA = 0, F_VA = 12582912, F_Q = 25165824, F_KK = 37748736, F_VV = 40894464, F_RKV = 44040192,
                 F_LORA = 81788928, F_GD = 88080384, P_ELEMS = 91226112;
constexpr size_t OFF_Y = OFF_P + P_ELEMS * 2;
constexpr size_t Y_ELEMS = 25165824;
constexpr size_t OFF_ST = OFF_Y + Y_ELEMS * 2;
constexpr size_t WS_END = OFF_ST + (size_t)2 * TT * 2 * 4;
constexpr size_t OFF_HID = OFF_W + W_IN * 2;
constexpr size_t OFF_H = OFF_Y;
static_assert(OFF_HID + (size_t)TT * 4096 * 2 <= OFF_Y, "HID overlaps H");
constexpr size_t O_NCK = 25165824, O_NCV = 27262976, O_NST = 29360128;

constexpr int SMEM_BYTES = 73728;

struct Params {
  const float *x_prompt, *x_sample, *cache_k, *cache_v, *state_wkv, *c, *c_ctx, *w_ada, *b_ada, *w_in,
      *sgu_ln_g, *sgu_ln_b, *sgu_w, *sgu_b, *q_norm, *k_norm, *rwkv_mu, *rwkv_w0, *rwkv_w2, *rwkv_a0, *rwkv_a2,
      *rwkv_k_k, *rwkv_k_a, *rwkv_r_k, *rwkv_g2, *rwkv_lnx_g, *rwkv_lnx_b, *w_branch, *w_out, *ln1_g, *ln1_b,
      *w_up, *w_down, *ln2_g, *ln2_b;
  float* out;
  unsigned char* ws;
};

typedef __attribute__((ext_vector_type(2))) float f32x2;
typedef __attribute__((ext_vector_type(2))) __bf16 bf16x2_t;
typedef __attribute__((ext_vector_type(4))) unsigned u32x4;
DEV unsigned pk2(float a, float b) { f32x2 v = {a, b}; return __builtin_bit_cast(unsigned, __builtin_convertvector(v, bf16x2_t)); }
DEV u16 f2bf(float f) { return (u16)(pk2(f, 0.f) & 0xffffu); }
DEV float bf2f(u16 h) { return __uint_as_float(((unsigned)h) << 16); }
DEV float bfs(short h) { return __uint_as_float(((unsigned)(u16)h) << 16); }
DEV float frcp(float x) { return __builtin_amdgcn_rcpf(x); }
DEV float sigmoidf_(float x) { return frcp(1.f + __expf(-x)); }
DEV bf16x8 pack8(const float* f) {
  u32x4 r = {pk2(f[0], f[1]), pk2(f[2], f[3]), pk2(f[4], f[5]), pk2(f[6], f[7])};
  return __builtin_bit_cast(bf16x8, r);
}
DEV void unpack8(bf16x8 v, float* f) {
#pragma unroll
  for (int i = 0; i < 8; ++i) f[i] = bfs(v[i]);
}
DEV float dpp_xor1(float x) { return __int_as_float(__builtin_amdgcn_update_dpp(0, __float_as_int(x), 0xB1, 0xF, 0xF, true)); }
DEV float dpp_xor2(float x) { return __int_as_float(__builtin_amdgcn_update_dpp(0, __float_as_int(x), 0x4E, 0xF, 0xF, true)); }
DEV float dpp_hmirror(float x) { return __int_as_float(__builtin_amdgcn_update_dpp(0, __float_as_int(x), 0x141, 0xF, 0xF, true)); }
DEV float dpp_mirror(float x) { return __int_as_float(__builtin_amdgcn_update_dpp(0, __float_as_int(x), 0x140, 0xF, 0xF, true)); }
DEV float shx(float v, int mask, int lane) { return __int_as_float(__builtin_amdgcn_ds_bpermute((lane ^ mask) << 2, __float_as_int(v))); }
DEV float wave_sum(float x, int lane) {
  x += dpp_xor1(x); x += dpp_xor2(x); x += dpp_hmirror(x); x += dpp_mirror(x);
  x += shx(x, 16, lane); x += shx(x, 32, lane);
  return x;
}
DEV f32x4 mfma16(bf16x8 a, bf16x8 b, f32x4 c) { return __builtin_amdgcn_mfma_f32_16x16x32_bf16(a, b, c, 0, 0, 0); }

typedef const __attribute__((address_space(4))) Params* PPtr;
DEV PPtr launder_p(PPtr q) { asm volatile("" : "+s"(q)); return q; }
DEV int tid_() { int t = threadIdx.x; asm volatile("" : "+v"(t)); return t; }
DEV int cv_of(int t) { return t < TCTX ? 0 : 1 + ((t - TCTX) >> 11); }

struct ABf16 {
  const u16* base; int ld;
  DEV bf16x8 operator()(int row, int k) const { return *(const bf16x8*)(base + (size_t)row * ld + k); }
};
struct ASig {
  const u16* base; int ld;
  DEV bf16x8 operator()(int row, int k) const {
    bf16x8 v = *(const bf16x8*)(base + (size_t)row * ld + k);
    float f[8]; unpack8(v, f);
#pragma unroll
    for (int i = 0; i < 8; ++i) f[i] = sigmoidf_(f[i]);
    return pack8(f);
  }
};
struct AModX {
  const float* xrow0; const float* sc; const float* sh;
  DEV bf16x8 operator()(int row, int k) const {
    const float* xr = xrow0 + (size_t)row * 1024 + k;
    float4 x0 = *(const float4*)xr, x1 = *(const float4*)(xr + 4);
    float4 s0 = *(const float4*)(sc + k), s1 = *(const float4*)(sc + k + 4);
    float4 h0 = *(const float4*)(sh + k), h1 = *(const float4*)(sh + k + 4);
    float f[8];
    f[0] = x0.x * (1.f + s0.x) + h0.x; f[1] = x0.y * (1.f + s0.y) + h0.y;
    f[2] = x0.z * (1.f + s0.z) + h0.z; f[3] = x0.w * (1.f + s0.w) + h0.w;
    f[4] = x1.x * (1.f + s1.x) + h1.x; f[5] = x1.y * (1.f + s1.y) + h1.y;
    f[6] = x1.z * (1.f + s1.z) + h1.z; f[7] = x1.w * (1.f + s1.w) + h1.w;
    return pack8(f);
  }
};

template <int MT, class AL>
DEV void gemm_mainloop(f32x4 (&acc)[MT][4], const AL& aload, const u16* __restrict__ Bt, int ldb, int K, u16* As, u16* Bs) {
  const int tid = tid_(), lane = tid & 63, wave = tid >> 6;
  const int wr = wave >> 1, wc = wave & 1, l15 = lane & 15, quad = lane >> 4;
  bf16x8 ra[MT], rb[4];
#pragma unroll
  for (int i = 0; i < MT; ++i) { int c = tid + i * 256; ra[i] = aload(c >> 3, (c & 7) * 8); }
#pragma unroll
  for (int i = 0; i < 4; ++i) { int c = tid + i * 256; rb[i] = *(const bf16x8*)(Bt + (size_t)(c >> 3) * ldb + (c & 7) * 8); }
  const int nk = K >> 6;
#pragma unroll 1
  for (int kt = 0; kt < nk; ++kt) {
    __syncthreads();
#pragma unroll
    for (int i = 0; i < MT; ++i) { int c = tid + i * 256; *(bf16x8*)(As + (c >> 3) * 72 + (c & 7) * 8) = ra[i]; }
#pragma unroll
    for (int i = 0; i < 4; ++i) { int c = tid + i * 256; *(bf16x8*)(Bs + (c >> 3) * 72 + (c & 7) * 8) = rb[i]; }
    __syncthreads();
    if (kt + 1 < nk) {
      const int k0 = (kt + 1) << 6;
#pragma unroll
      for (int i = 0; i < MT; ++i) { int c = tid + i * 256; ra[i] = aload(c >> 3, k0 + (c & 7) * 8); }
#pragma unroll
      for (int i = 0; i < 4; ++i) { int c = tid + i * 256; rb[i] = *(const bf16x8*)(Bt + (size_t)(c >> 3) * ldb + k0 + (c & 7) * 8); }
    }
#pragma unroll
    for (int ks = 0; ks < 2; ++ks) {
      bf16x8 a[MT], b[4];
#pragma unroll
      for (int m = 0; m < MT; ++m) a[m] = *(const bf16x8*)(As + (wr * MT * 16 + m * 16 + l15) * 72 + ks * 32 + quad * 8);
#pragma unroll
      for (int n = 0; n < 4; ++n) b[n] = *(const bf16x8*)(Bs + (wc * 64 + n * 16 + l15) * 72 + ks * 32 + quad * 8);
#pragma unroll
      for (int m = 0; m < MT; ++m)
#pragma unroll
        for (int n = 0; n < 4; ++n) acc[m][n] = mfma16(a[m], b[n], acc[m][n]);
    }
  }
}

template <int MT, bool HOIST = true>
DEV void gemm_mainloop_dma(f32x4 (&acc)[MT][4], const u16* __restrict__ A, int lda, const u16* __restrict__ Bt, int ldb, int K, unsigned char* smem,
                           bool pre = false, const u16* nA = nullptr, int nlda = 0, const u16* nBt = nullptr, int nldb = 0) {
  const int tid = tid_(), lane = tid & 63, wave = tid >> 6;
  const int wr = wave >> 1, wc = wave & 1, l15 = lane & 15, quad = lane >> 4;
  const int prow = tid >> 3, pkc = ((tid & 7) ^ ((tid >> 3) & 7)) * 8;
  const u16* ga = A + (size_t)prow * lda + pkc;
  const u16* gb = Bt + (size_t)prow * ldb + pkc;
  const int nk = K >> 6;
  const int sw = l15 & 7;
  const int slot0 = ((quad) ^ sw) * 16, slot1 = ((4 + quad) ^ sw) * 16;
  const int arow = (wr * MT * 16 + l15) * 128, brow = (wc * 64 + l15) * 128;
  if (!pre) {
    __syncthreads();
    unsigned char* sa = smem + tid * 16;
#pragma unroll
    for (int i = 0; i < MT; ++i) __builtin_amdgcn_global_load_lds((const unsigned*)(ga + (size_t)i * 32 * lda), (unsigned*)(sa + i * 4096), 16, 0, 0);
#pragma unroll
    for (int i = 0; i < 4; ++i) __builtin_amdgcn_global_load_lds((const unsigned*)(gb + (size_t)i * 32 * ldb), (unsigned*)(sa + 16384 + i * 4096), 16, 0, 0);
  }
#pragma unroll 1
  for (int kt = 0; kt < nk; ++kt) {
    asm volatile("s_waitcnt vmcnt(0)" ::: "memory");
    __syncthreads();
    if (kt + 1 < nk) {
      unsigned char* sa = smem + ((kt + 1) & 1) * 32768 + tid * 16;
      const int k0 = (kt + 1) << 6;
#pragma unroll
      for (int i = 0; i < MT; ++i) __builtin_amdgcn_global_load_lds((const unsigned*)(ga + (size_t)i * 32 * lda + k0), (unsigned*)(sa + i * 4096), 16, 0, 0);
#pragma unroll
      for (int i = 0; i < 4; ++i) __builtin_amdgcn_global_load_lds((const unsigned*)(gb + (size_t)i * 32 * ldb + k0), (unsigned*)(sa + 16384 + i * 4096), 16, 0, 0);
    } else if (nA) {
      unsigned char* sa = smem + tid * 16;
      const u16* na = nA + (size_t)prow * nlda + pkc;
      const u16* nb = nBt + (size_t)prow * nldb + pkc;
#pragma unroll
      for (int i = 0; i < MT; ++i) __builtin_amdgcn_global_load_lds((const unsigned*)(na + (size_t)i * 32 * nlda), (unsigned*)(sa + i * 4096), 16, 0, 0);
#pragma unroll
      for (int i = 0; i < 4; ++i) __builtin_amdgcn_global_load_lds((const unsigned*)(nb + (size_t)i * 32 * nldb), (unsigned*)(sa + 16384 + i * 4096), 16, 0, 0);
    }
    const unsigned char* ab = smem + (kt & 1) * 32768;
    const unsigned char* bb = ab + 16384;
    if (!HOIST) {
#pragma unroll
      for (int ks = 0; ks < 2; ++ks) {
        const int slot = ks ? slot1 : slot0;
        bf16x8 a[MT], b[4];
#pragma unroll
        for (int m = 0; m < MT; ++m) a[m] = *(const bf16x8*)(ab + arow + m * 2048 + slot);
#pragma unroll
        for (int n = 0; n < 4; ++n) b[n] = *(const bf16x8*)(bb + brow + n * 2048 + slot);
        __builtin_amdgcn_sched_barrier(0);
#pragma unroll
        for (int m = 0; m < MT; ++m)
#pragma unroll
          for (int n = 0; n < 4; ++n) acc[m][n] = mfma16(a[m], b[n], acc[m][n]);
        __builtin_amdgcn_sched_barrier(0);
      }
      continue;
    }
    bf16x8 a0[MT], b0[4], a1[MT], b1[4];
#pragma unroll
    for (int m = 0; m < MT; ++m) a0[m] = *(const bf16x8*)(ab + arow + m * 2048 + slot0);
#pragma unroll
    for (int n = 0; n < 4; ++n) b0[n] = *(const bf16x8*)(bb + brow + n * 2048 + slot0);
#pragma unroll
    for (int m = 0; m < MT; ++m) a1[m] = *(const bf16x8*)(ab + arow + m * 2048 + slot1);
#pragma unroll
    for (int n = 0; n < 4; ++n) b1[n] = *(const bf16x8*)(bb + brow + n * 2048 + slot1);
    __builtin_amdgcn_sched_barrier(0);
#pragma unroll
    for (int m = 0; m < MT; ++m)
#pragma unroll
      for (int n = 0; n < 4; ++n) acc[m][n] = mfma16(a0[m], b0[n], acc[m][n]);
#pragma unroll
    for (int m = 0; m < MT; ++m)
#pragma unroll
      for (int n = 0; n < 4; ++n) acc[m][n] = mfma16(a1[m], b1[n], acc[m][n]);
  }
}

template <int MT>
DEV void zero_acc(f32x4 (&acc)[MT][4]) {
#pragma unroll
  for (int m = 0; m < MT; ++m)
#pragma unroll
    for (int n = 0; n < 4; ++n) acc[m][n] = (f32x4){0.f, 0.f, 0.f, 0.f};
}

template <int MT, class F>
DEV void epi_foreach(f32x4 (&acc)[MT][4], F f) {
  const int tid = tid_(); const int lane = tid & 63, wave = tid >> 6;
  const int wr = wave >> 1, wc = wave & 1, l15 = lane & 15, quad = lane >> 4;
#pragma unroll
  for (int m = 0; m < MT; ++m)
#pragma unroll
    for (int n = 0; n < 4; ++n)
#pragma unroll
      for (int j = 0; j < 4; ++j) f(wr * MT * 16 + m * 16 + quad * 4 + j, wc * 64 + n * 16 + l15, acc[m][n][j]);
}

template <int MT, class F>
DEV void epi_bf16(f32x4 (&acc)[MT][4], u16* Ct, u16* dst, int ld, F f) {
  __syncthreads();
  epi_foreach<MT>(acc, [&](int r, int c, float v) { Ct[r * 136 + c] = f2bf(f(r, c, v)); });
  __syncthreads();
  const int tid = tid_();
#pragma unroll
  for (int i = 0; i < MT * 2; ++i) {
    const int c = tid + i * 256, row = c >> 4, cc = (c & 15) * 8;
    *(bf16x8*)(dst + (size_t)row * ld + cc) = *(const bf16x8*)(Ct + row * 136 + cc);
  }
}
template <class G>
DEV void epi_f32(f32x4 (&acc)[4][4], float* Cf, G g) {
  const int tid = tid_(), lane = tid & 63, wave = tid >> 6;
  const int wr = wave >> 1, wc = wave & 1, l15 = lane & 15, quad = lane >> 4;
#pragma unroll 1
  for (int half = 0; half < 2; ++half) {
    __syncthreads();
    if (wr == half) {
#pragma unroll
      for (int m = 0; m < 4; ++m)
#pragma unroll
        for (int n = 0; n < 4; ++n)
#pragma unroll
          for (int j = 0; j < 4; ++j) Cf[(m * 16 + quad * 4 + j) * 132 + wc * 64 + n * 16 + l15] = acc[m][n][j];
    }
    __syncthreads();
#pragma unroll 4
    for (int i = 0; i < 8; ++i) {
      const int c = tid + i * 256, row = c >> 5, cc = (c & 31) * 4;
      g(half * 64 + row, cc, *(const float4*)(Cf + row * 132 + cc));
    }
  }
}

#define XB_TMO 128
#define XB_XCNT(j) (256 + 64 * (j))
#define XB_XSUB(j) (1280 + 64 * (j))
#define XB_XGEN(j) (2304 + 64 * (j))
#define XB_TOP 3328
#define XB_TOPGEN 3392
#define XB_SPIN_CAP (1u << 20)
constexpr size_t OFF_XB = 499712;
DEV unsigned xb_ld(unsigned* q) { return __hip_atomic_load(q, __ATOMIC_RELAXED, __HIP_MEMORY_SCOPE_AGENT); }
DEV unsigned xb_add(unsigned* q, unsigned v) { return __hip_atomic_fetch_add(q, v, __ATOMIC_RELAXED, __HIP_MEMORY_SCOPE_AGENT); }
#define XB_SPIN(cond, bar)                                                                                         \
  do {                                                                                                             \
    unsigned _sp = 0;                                                                                              \
    while (cond) {                                                                                                 \
      __builtin_amdgcn_s_sleep(1);                                                                                 \
      if ((++_sp & 255u) == 0u) { if (xb_ld(&(bar)[XB_TMO])) break; if (_sp > XB_SPIN_CAP) { atomicAdd(&(bar)[XB_TMO], 1u); break; } } \
    }                                                                                                              \
  } while (0)
DEV void xb_complete(unsigned* bar, unsigned x, unsigned& nloc, unsigned& nx) {
  const unsigned G = gridDim.x;
  unsigned sum, cnt, mine, sp = 0u;
  for (;;) {
    sum = 0u; cnt = 0u; mine = 0u;
#pragma unroll 1
    for (unsigned j = 0; j < 16; ++j) { const unsigned c = xb_ld(&bar[XB_XCNT(j)]); sum += c; cnt += (c > 0u) ? 1u : 0u; mine = (j == x) ? c : mine; }
    if (sum == G) break;
    __builtin_amdgcn_s_sleep(1);
    if ((++sp & 255u) == 0u) { if (xb_ld(&bar[XB_TMO])) break; if (sp > XB_SPIN_CAP) { atomicAdd(&bar[XB_TMO], 1u); break; } }
  }
  nloc = mine > 0u ? mine : 1u; nx = cnt > 0u ? cnt : 1u;
}
DEV void gbar(unsigned* bar, unsigned char* smem) {
  unsigned* st = (unsigned*)(smem + SMEM_BYTES - 8);
  asm volatile("s_waitcnt vmcnt(0)" ::: "memory");
  __syncthreads();
  if (tid_() == 0) {
    __builtin_amdgcn_s_waitcnt(0);
    const unsigned x = (unsigned)__builtin_amdgcn_s_getreg((3 << 11) | 20) & 0xFu;
    unsigned nloc = st[0], nx = st[1];
    if (nloc == 0u) { xb_complete(bar, x, nloc, nx); st[0] = nloc; st[1] = nx; }
    const unsigned old = xb_add(&bar[XB_XSUB(x)], 1u);
    const unsigned gen = old / nloc;
    if (old + 1u == (gen + 1u) * nloc) {
      __builtin_amdgcn_fence(__ATOMIC_RELEASE, "agent");
      asm volatile("s_waitcnt vmcnt(0)" ::: "memory");
      const unsigned og = xb_add(&bar[XB_TOP], 1u);
      const unsigned tg = og / nx;
      if (og + 1u == (tg + 1u) * nx) xb_add(&bar[XB_TOPGEN], 1u);
      else XB_SPIN(xb_ld(&bar[XB_TOPGEN]) == tg, bar);
      __builtin_amdgcn_fence(__ATOMIC_ACQUIRE, "agent");
      xb_add(&bar[XB_XGEN(x)], 1u);
      asm volatile("s_waitcnt vmcnt(0)" ::: "memory");
    } else {
      XB_SPIN(xb_ld(&bar[XB_XGEN(x)]) == gen, bar);
      __builtin_amdgcn_fence(__ATOMIC_ACQUIRE, "agent");
      asm volatile("s_waitcnt vmcnt(0)" ::: "memory");
    }
  }
  __syncthreads();
}

DEV void transpose_tile(const float* __restrict__ src, int K, int N, u16* __restrict__ dst, int tile, float* sm) {
  const int tn = N >> 6;
  const int k0 = (tile / tn) * 64, n0 = (tile % tn) * 64;
  const int tid = tid_();
  __syncthreads();
#pragma unroll
  for (int i = 0; i < 4; ++i) {
    const int k = i * 16 + (tid >> 4), n = (tid & 15) * 4;
    const float4 v4 = *(const float4*)(src + (size_t)(k0 + k) * N + n0 + n);
    sm[k * 65 + n] = v4.x; sm[k * 65 + n + 1] = v4.y; sm[k * 65 + n + 2] = v4.z; sm[k * 65 + n + 3] = v4.w;
  }
  __syncthreads();
  const int n = tid >> 2, kc = (tid & 3) * 16;
  bf16x8 o0, o1;
#pragma unroll
  for (int i = 0; i < 8; ++i) { o0[i] = (short)f2bf(sm[(kc + i) * 65 + n]); o1[i] = (short)f2bf(sm[(kc + 8 + i) * 65 + n]); }
  u16* d = dst + (size_t)(n0 + n) * K + k0 + kc;
  *(bf16x8*)d = o0; *(bf16x8*)(d + 8) = o1;
}

DEV void mod_unit(PPtr p, int u, float* sm) {
  const int l2 = u / 96, n0 = (u % 96) * 64, tid = tid_();
  float* sc = sm; float* red = sm + 9216;
  __syncthreads();
  for (int i = tid; i < 9216; i += 256) {
    int cv = i >> 10, k = i & 1023;
    float x = cv == 0 ? p->c_ctx[k] : p->c[(cv - 1) * 1024 + k];
    sc[i] = x / (1.f + __expf(-x));
  }
  __syncthreads();
  const int kq = tid >> 6, col = tid & 63;
  float acc[9];
#pragma unroll
  for (int cv = 0; cv < 9; ++cv) acc[cv] = 0.f;
  const float* w = p->w_ada + ((size_t)l2 * 1024 + kq * 256) * 6144 + n0 + col;
#pragma unroll 4
  for (int k = 0; k < 256; ++k) {
    float wv = w[(size_t)k * 6144];
#pragma unroll
    for (int cv = 0; cv < 9; ++cv) acc[cv] += sc[cv * 1024 + kq * 256 + k] * wv;
  }
#pragma unroll
  for (int cv = 0; cv < 9; ++cv) red[(kq * 9 + cv) * 64 + col] = acc[cv];
  __syncthreads();
  float* MOD = (float*)(p->ws + OFF_MOD);
  for (int i = tid; i < 576; i += 256) {
    int cv = i >> 6, cc = i & 63;
    float s = red[(0 * 9 + cv) * 64 + cc] + red[(1 * 9 + cv) * 64 + cc] + red[(2 * 9 + cv) * 64 + cc] + red[(3 * 9 + cv) * 64 + cc];
    MOD[(size_t)(l2 * 9 + cv) * 6144 + n0 + cc] = s + p->b_ada[l2 * 6144 + n0 + cc];
  }
}

DEV void phase_convert(PPtr p, int l, unsigned char* smem) {
  float* sm = (float*)smem;
  u16* W = (u16*)(p->ws + OFF_W);
  const int tidc = tid_();
  const int total = (l == 0) ? 4448 + 1536 : 4448;
  for (int id = blockIdx.x; id < total; id += gridDim.x) {
    if (id < 1696) transpose_tile(p->w_in + (size_t)l * 1024 * 6784, 1024, 6784, W + W_IN, id, sm);
    else if (id < 2080) { int j = (id - 1696) >> 7; transpose_tile(p->w_branch + (size_t)(l * 3 + j) * 512 * 1024, 512, 1024, W + W_BR + (size_t)j * 1024 * 512, (id - 1696) & 127, sm); }
    else if (id < 2336) transpose_tile(p->w_out + (size_t)l * 1024 * 1024, 1024, 1024, W + W_OUT, id - 2080, sm);
    else if (id < 3360) transpose_tile(p->w_up + (size_t)l * 1024 * 4096, 1024, 4096, W + W_UP, id - 2336, sm);
    else if (id < 4384) transpose_tile(p->w_down + (size_t)l * 4096 * 1024, 4096, 1024, W + W_DOWN, id - 3360, sm);
    else if (id < 4400) { int d = (id - 4384) >> 3; transpose_tile(p->rwkv_w2 + (size_t)(l * 2 + d) * 64 * 512, 64, 512, W + W_W2 + (size_t)d * 512 * 64, (id - 4384) & 7, sm); }
    else if (id < 4416) { int d = (id - 4400) >> 3; transpose_tile(p->rwkv_a2 + (size_t)(l * 2 + d) * 64 * 512, 64, 512, W + W_A2 + (size_t)d * 512 * 64, (id - 4400) & 7, sm); }
    else if (id < 4432) transpose_tile(p->rwkv_g2 + (size_t)l * 128 * 512, 128, 512, W + W_G2, id - 4416, sm);
    else if (id < 4448) {
      const float* src = p->sgu_w + (size_t)l * 65536 + (id - 4432) * 4096 + tidc * 16;
      u16* dst = W + W_SGU + (id - 4432) * 4096 + tidc * 16;
      float f[16];
#pragma unroll
      for (int i = 0; i < 4; ++i) { float4 v = *(const float4*)(src + i * 4); f[i * 4] = v.x; f[i * 4 + 1] = v.y; f[i * 4 + 2] = v.z; f[i * 4 + 3] = v.w; }
      *(bf16x8*)dst = pack8(f); *(bf16x8*)(dst + 8) = pack8(f + 8);
    } else {
      const int r0 = (id - 4448) * 16;
      const float* xr0 = r0 < TCTX ? p->x_prompt + (size_t)r0 * 1024 : p->x_sample + (size_t)(r0 - TCTX) * 1024;
      const float* mod = (const float*)(p->ws + OFF_MOD) + (size_t)cv_of(r0) * 6144;
      u16* H = (u16*)(p->ws + OFF_H) + (size_t)r0 * 1024;
#pragma unroll 2
      for (int i = 0; i < 8; ++i) {
        const int c = tidc + i * 256, row = c >> 7, kc = (c & 127) * 8;
        AModX al{xr0, mod + 1024, mod};
        *(bf16x8*)(H + (size_t)row * 1024 + kc) = al(row, kc);
      }
    }
  }
}

DEV int vblock() { const int G = gridDim.x, b = blockIdx.x; return (G & 7) == 0 ? (b & 7) * (G >> 3) + (b >> 3) : b; }
DEV void tile_map(int id, int NT, int& mt, int& nt) { const int g = id / (8 * NT), r = id - g * 8 * NT; nt = r >> 3; mt = g * 8 + (r & 7); }

constexpr size_t OFF_GQ = 491520;
struct TQ { unsigned* q; int nt; int xcc; int tries; };
DEV int xcc_id() { return (int)(__builtin_amdgcn_s_getreg((3 << 11) | 20) & 7u); }
DEV int tq_pull(TQ& t, int* slot, int tid) {
  __syncthreads();
  if (tid == 0) {
    int id = -1;
    while (t.tries < 8) {
      const int x = (t.xcc + t.tries) & 7;
      const int start = (t.nt * x) >> 3, end = (t.nt * (x + 1)) >> 3;
      const int k = (int)atomicAdd(t.q + x * 16, 1u);
      if (start + k < end) { id = start + k; break; }
      ++t.tries;
    }
    *slot = id;
  }
  __syncthreads();
  return *slot;
}

DEV void inproj_qk_epilogue(PPtr p, int l, f32x4 (&acc)[4][4], u16* Ct, int m0, int nt) {
  __syncthreads();
  epi_foreach<4>(acc, [&](int r, int c, float v) { Ct[r * 136 + c] = f2bf(v); });
  __syncthreads();
  const int tid = tid_(), s = tid & 7;
  const bool isk = nt == 12;
  u16* Qf = (u16*)(p->ws + OFF_P) + F_Q;
  u16* KC = (u16*)(p->ws + OFF_KC);
  const float* g = (isk ? p->k_norm : p->q_norm) + l * 64 + s * 8;
#pragma unroll 1
  for (int it = 0; it < 8; ++it) {
    const int slot = it * 256 + tid, pair = slot >> 3, row = pair >> 1, hd = pair & 1;
    const int t = m0 + row;
    const bool lat = t >= TCTX;
    const int b = lat ? (t - TCTX) >> 11 : t >> 8;
    const int pos = lat ? (t - TCTX) & 2047 : t & 255;
    float f[8]; unpack8(*(const bf16x8*)(Ct + row * 136 + hd * 64 + s * 8), f);
    float ss = 0.f;
#pragma unroll
    for (int i = 0; i < 8; ++i) ss += f[i] * f[i];
    ss += dpp_xor1(ss); ss += dpp_xor2(ss); ss += dpp_hmirror(ss);
    const float rs = rsqrtf(ss * (1.f / 64.f) + 1e-6f);
#pragma unroll
    for (int i = 0; i < 8; ++i) f[i] = f[i] * rs * g[i];
    if (lat) {
      const float posv = (float)((s < 4) ? (pos >> 6) : (pos & 63));
#pragma unroll
      for (int i = 0; i < 8; ++i) {
        const float fi = (float)((s & 1) * 8 + i);
        const float ang = posv * exp2f(-fi * (13.287712379549449f / 16.f));
        const float cs = __cosf(ang), sn = __sinf(ang);
        const float pf = dpp_xor2(f[i]);
        f[i] = (s & 2) ? (f[i] * cs + pf * sn) : (f[i] * cs - pf * sn);
      }
    }
    const bf16x8 o = pack8(f);
    if (!isk) *(bf16x8*)(Qf + (size_t)t * 512 + (nt - 8) * 128 + hd * 64 + s * 8) = o;
    else if (lat) *(bf16x8*)(KC + KC_LAT + ((size_t)(b * 2 + hd) * 2560 + 512 + pos) * 64 + s * 8) = o;
    else {
      *(bf16x8*)(KC + ((size_t)(b * 2 + hd) * 256 + pos) * 64 + s * 8) = o;
      float* d = p->out + O_NCK + ((((size_t)b * 2 + l) * 256 + pos) * 2 + hd) * 64 + s * 8;
      *(float4*)d = make_float4(f[0], f[1], f[2], f[3]);
      *(float4*)(d + 4) = make_float4(f[4], f[5], f[6], f[7]);
    }
  }
}
DEV void inproj_v_epilogue(PPtr p, int l, f32x4 (&acc)[4][4], u16* Ct, int m0) {
  __syncthreads();
  epi_foreach<4>(acc, [&](int r, int c, float v) { Ct[r * 136 + c] = f2bf(v); });
  __syncthreads();
  const int tid = tid_();
  u16* VT = (u16*)(p->ws + OFF_VT);
  const bool lat = m0 >= TCTX;
  const int b = lat ? (m0 - TCTX) >> 11 : m0 >> 8;
  const int pos0 = lat ? (m0 - TCTX) & 2047 : m0 & 255;
  if (!lat) {
#pragma unroll 2
    for (int i = 0; i < 8; ++i) {
      const int c = tid + i * 256, row = c >> 4, cc = (c & 15) * 8;
      float f[8]; unpack8(*(const bf16x8*)(Ct + row * 136 + cc), f);
      float* d = p->out + O_NCV + ((((size_t)b * 2 + l) * 256 + pos0 + row) * 2 + (cc >> 6)) * 64 + (cc & 63);
      *(float4*)d = make_float4(f[0], f[1], f[2], f[3]);
      *(float4*)(d + 4) = make_float4(f[4], f[5], f[6], f[7]);
    }
  }
#pragma unroll 2
  for (int i = 0; i < 8; ++i) {
    const int c = tid + i * 256, kvh = c >> 10, d = (c >> 4) & 63, kc = c & 15;
    bf16x8 o;
#pragma unroll
    for (int e = 0; e < 8; ++e) o[e] = (short)Ct[(kc * 8 + e) * 136 + kvh * 64 + d];
    u16* dst = lat ? VT + KC_LAT + ((size_t)(b * 2 + kvh) * 64 + d) * 2560 + 512 + pos0 + kc * 8
                   : VT + ((size_t)(b * 2 + kvh) * 64 + d) * 256 + pos0 + kc * 8;
    *(bf16x8*)dst = o;
  }
}
DEV void cache_tile(PPtr p, int l, int u, unsigned char* smem) {
  u16* KC = (u16*)(p->ws + OFF_KC);
  u16* VT = (u16*)(p->ws + OFF_VT);
  const int tid = tid_();
  const int b = u >> 4, kvh = (u >> 3) & 1, kb = u & 7;
  u16* tile = (u16*)smem;
  const int key = tid >> 2, dc = (tid & 3) * 16;
  float f[16], fk[16];
  __syncthreads();
  const int pk = kb * 64 + key;
  const float* sv = p->cache_v + (((size_t)(b * 2 + l) * 512 + pk) * 2 + kvh) * 64 + dc;
  const float* sk = p->cache_k + (((size_t)(b * 2 + l) * 512 + pk) * 2 + kvh) * 64 + dc;
#pragma unroll
  for (int i = 0; i < 4; ++i) {
    float4 v = *(const float4*)(sv + i * 4); f[i * 4] = v.x; f[i * 4 + 1] = v.y; f[i * 4 + 2] = v.z; f[i * 4 + 3] = v.w;
    float4 k = *(const float4*)(sk + i * 4); fk[i * 4] = k.x; fk[i * 4 + 1] = k.y; fk[i * 4 + 2] = k.z; fk[i * 4 + 3] = k.w;
  }
  u16* kd = KC + KC_LAT + ((size_t)(b * 2 + kvh) * 2560 + pk) * 64 + dc;
  *(bf16x8*)kd = pack8(fk); *(bf16x8*)(kd + 8) = pack8(fk + 8);
#pragma unroll
  for (int i = 0; i < 16; ++i) tile[(dc + i) * 72 + key] = f2bf(f[i]);
  __syncthreads();
  const int d = tid >> 2, kc = (tid & 3) * 16;
  bf16x8 o0 = *(const bf16x8*)(tile + d * 72 + kc), o1 = *(const bf16x8*)(tile + d * 72 + kc + 8);
  u16* dst = VT + KC_LAT + ((size_t)(b * 2 + kvh) * 64 + d) * 2560 + kb * 64 + kc;
  *(bf16x8*)dst = o0; *(bf16x8*)(dst + 8) = o1;
}

DEV void phase_inproj(PPtr p, int l, unsigned char* smem) {
  u16* Ct = (u16*)(smem + 32768);
  const u16* W = (const u16*)(p->ws + OFF_W);
  const u16* H = (const u16*)(p->ws + OFF_H);
  u16* P = (u16*)(p->ws + OFF_P);
  TQ tq{(unsigned*)(p->ws + OFF_GQ) + (l * 5 + 0) * 128, 192 * 29, xcc_id(), 0};
  int* slot = (int*)(smem + SMEM_BYTES - 16);
  const int tidq = tid_();
  bool pre = false;
  int id = tq_pull(tq, slot, tidq);
  while (id >= 0) {
    int mt, nt; tile_map(id, 29, mt, nt);
    const int m0 = mt * 128, n0 = nt * 128;
    const int idn = tq_pull(tq, slot, tidq); const bool hn = idn >= 0;
    int mtn = 0, ntn = 0; if (hn) tile_map(idn, 29, mtn, ntn);
    f32x4 acc[4][4]; zero_acc<4>(acc);
    gemm_mainloop_dma<4>(acc, H + (size_t)m0 * 1024, 1024, W + W_IN + (size_t)n0 * 1024, 1024, 1024, smem, pre,
                         hn ? H + (size_t)mtn * 128 * 1024 : nullptr, 1024, W + W_IN + (size_t)ntn * 128 * 1024, 1024);
    pre = hn;
    if (nt >= 8 && nt <= 12) { inproj_qk_epilogue(p, l, acc, Ct, m0, nt); id = idn; continue; }
    if (nt == 13) { inproj_v_epilogue(p, l, acc, Ct, m0); id = idn; continue; }
    u16* dst; int ld;
    if (n0 < 512) { dst = P + F_UA + n0; ld = 512; }
    else if (n0 < 1024) { dst = P + F_VA + (n0 - 512); ld = 512; }
    else if (n0 < 1536) { dst = P + F_Q + (n0 - 1024); ld = 512; }
    else if (n0 < 1664) { dst = P + F_KK; ld = 128; }
    else if (n0 < 1792) { dst = P + F_VV; ld = 128; }
    else if (n0 < 3328) { dst = P + F_RKV + (n0 - 1792); ld = 1536; }
    else if (n0 < 3584) { dst = P + F_LORA + (n0 - 3328); ld = 256; }
    else { dst = P + F_GD; ld = 128; }
    dst += (size_t)m0 * ld;
    epi_bf16<4>(acc, Ct, dst, ld, [](int, int, float v) { return v; });
    id = idn;
  }
  for (int u = blockIdx.x; u < 128; u += gridDim.x) cache_tile(p, l, u, smem);
}


DEV void attn_item(PPtr p, int item, bool lat, unsigned char* smem) {
  u16* Ks = (u16*)smem; u16* Vs = Ks + 64 * 72;
  u16* P = (u16*)(p->ws + OFF_P);
  const int tid = tid_(), lane = tid & 63, wave = tid >> 6, l15 = lane & 15, quad = lane >> 4;
  int b, kvh, qb, LK; size_t tq0; const u16 *Kc, *VTc;
  if (lat) {
    b = item >> 7; kvh = (item >> 6) & 1; qb = item & 63; LK = 2560;
    tq0 = TCTX + (size_t)b * 2048 + qb * 32;
    Kc = (const u16*)(p->ws + OFF_KC) + KC_LAT + (size_t)(b * 2 + kvh) * 2560 * 64;
    VTc = (const u16*)(p->ws + OFF_VT) + KC_LAT + (size_t)(b * 2 + kvh) * 64 * 2560;
  } else {
    b = item >> 4; kvh = (item >> 3) & 1; qb = item & 7; LK = 256;
    tq0 = (size_t)b * 256 + qb * 32;
    Kc = (const u16*)(p->ws + OFF_KC) + (size_t)(b * 2 + kvh) * 256 * 64;
    VTc = (const u16*)(p->ws + OFF_VT) + (size_t)(b * 2 + kvh) * 64 * 256;
  }
  const int hq = kvh * 4 + wave;
  bf16x8 qf[2][2];
#pragma unroll
  for (int qt = 0; qt < 2; ++qt)
#pragma unroll
    for (int ks = 0; ks < 2; ++ks) qf[qt][ks] = *(const bf16x8*)(P + F_Q + (tq0 + qt * 16 + l15) * 512 + hq * 64 + ks * 32 + quad * 8);
  f32x4 o[4][2];
#pragma unroll
  for (int dt = 0; dt < 4; ++dt)
#pragma unroll
    for (int qt = 0; qt < 2; ++qt) o[dt][qt] = (f32x4){0.f, 0.f, 0.f, 0.f};
  float mrow[2] = {-1e30f, -1e30f}, lrow[2] = {0.f, 0.f};
  const float C = 0.125f * 1.4426950408889634f;
  bf16x8 rk[2], rv[2];
#pragma unroll
  for (int i = 0; i < 2; ++i) {
    int c = tid + i * 256, r = c >> 3, cc = (c & 7) * 8;
    rk[i] = *(const bf16x8*)(Kc + (size_t)r * 64 + cc);
    rv[i] = *(const bf16x8*)(VTc + (size_t)r * LK + cc);
  }
  const int nt = LK >> 6;
  for (int kt = 0; kt < nt; ++kt) {
    __syncthreads();
#pragma unroll
    for (int i = 0; i < 2; ++i) {
      int c = tid + i * 256, r = c >> 3, cc = (c & 7) * 8;
      *(bf16x8*)(Ks + r * 72 + cc) = rk[i];
      *(bf16x8*)(Vs + r * 72 + cc) = rv[i];
    }
    __syncthreads();
    if (kt + 1 < nt) {
      const int key0 = (kt + 1) * 64;
#pragma unroll
      for (int i = 0; i < 2; ++i) {
        int c = tid + i * 256, r = c >> 3, cc = (c & 7) * 8;
        rk[i] = *(const bf16x8*)(Kc + (size_t)(key0 + r) * 64 + cc);
        rv[i] = *(const bf16x8*)(VTc + (size_t)r * LK + key0 + cc);
      }
    }
    f32x4 s[4][2];
#pragma unroll
    for (int nk = 0; nk < 4; ++nk)
#pragma unroll
      for (int qt = 0; qt < 2; ++qt) s[nk][qt] = (f32x4){0.f, 0.f, 0.f, 0.f};
#pragma unroll
    for (int ks = 0; ks < 2; ++ks)
#pragma unroll
      for (int nk = 0; nk < 4; ++nk) {
        bf16x8 a = *(const bf16x8*)(Ks + (nk * 16 + l15) * 72 + ks * 32 + quad * 8);
#pragma unroll
        for (int qt = 0; qt < 2; ++qt) s[nk][qt] = mfma16(a, qf[qt][ks], s[nk][qt]);
      }
#pragma unroll
    for (int qt = 0; qt < 2; ++qt) {
      float mx = -1e30f;
#pragma unroll
      for (int nk = 0; nk < 4; ++nk)
#pragma unroll
        for (int j = 0; j < 4; ++j) mx = fmaxf(mx, s[nk][qt][j]);
      mx = fmaxf(mx, shx(mx, 16, lane)); mx = fmaxf(mx, shx(mx, 32, lane));
      const float mnew = fmaxf(mrow[qt], mx);
      const float alpha = __builtin_amdgcn_exp2f((mrow[qt] - mnew) * C);
      mrow[qt] = mnew;
      lrow[qt] *= alpha;
#pragma unroll
      for (int dt = 0; dt < 4; ++dt) { o[dt][qt][0] *= alpha; o[dt][qt][1] *= alpha; o[dt][qt][2] *= alpha; o[dt][qt][3] *= alpha; }
      const float nmc = -mrow[qt] * C;
      float ls = 0.f;
#pragma unroll
      for (int nk = 0; nk < 4; ++nk)
#pragma unroll
        for (int j = 0; j < 4; ++j) { float pv = __builtin_amdgcn_exp2f(__builtin_fmaf(s[nk][qt][j], C, nmc)); ls += pv; s[nk][qt][j] = pv; }
      lrow[qt] += ls;
    }
#pragma unroll
    for (int ks = 0; ks < 2; ++ks) {
      bf16x8 pf[2];
#pragma unroll
      for (int qt = 0; qt < 2; ++qt) {
#pragma unroll
        for (int j = 0; j < 4; ++j) { pf[qt][j] = (short)f2bf(s[2 * ks][qt][j]); pf[qt][4 + j] = (short)f2bf(s[2 * ks + 1][qt][j]); }
      }
#pragma unroll
      for (int dt = 0; dt < 4; ++dt) {
        const u16* vr = Vs + (dt * 16 + l15) * 72 + quad * 4;
        bf16x4 v0 = *(const bf16x4*)(vr + (2 * ks) * 16), v1 = *(const bf16x4*)(vr + (2 * ks + 1) * 16);
        bf16x8 a;
        a[0] = v0[0]; a[1] = v0[1]; a[2] = v0[2]; a[3] = v0[3]; a[4] = v1[0]; a[5] = v1[1]; a[6] = v1[2]; a[7] = v1[3];
#pragma unroll
        for (int qt = 0; qt < 2; ++qt) o[dt][qt] = mfma16(a, pf[qt], o[dt][qt]);
      }
    }
  }
#pragma unroll
  for (int qt = 0; qt < 2; ++qt) {
    float lsum = lrow[qt];
    lsum += shx(lsum, 16, lane); lsum += shx(lsum, 32, lane);
    const float inv = frcp(lsum);
#pragma unroll
    for (int dt = 0; dt < 4; ++dt) {
      bf16x4 ov;
#pragma unroll
      for (int j = 0; j < 4; ++j) ov[j] = (short)f2bf(o[dt][qt][j] * inv);
      *(bf16x4*)(P + F_Q + (tq0 + qt * 16 + l15) * 512 + hq * 64 + dt * 16 + quad * 4) = ov;
    }
  }
}

DEV void sgu_item(PPtr p, int l, int item, unsigned char* smem) {
  u16* VnT = (u16*)smem;
  float* stats = (float*)(smem + 128 * 136 * 2);
  u16* P = (u16*)(p->ws + OFF_P);
  const u16* Wsb = (const u16*)(p->ws + OFF_W) + W_SGU;
  const int tid = tid_(), lane = tid & 63, wave = tid >> 6, l15 = lane & 15, quad = lane >> 4;
  const int wr = wave >> 1, wc = wave & 1;
  const size_t t0 = (size_t)item * 128;
  __syncthreads();
  {
    const int tok = tid >> 1, half = tid & 1;
    const u16* vr = P + F_VA + (t0 + tok) * 512 + half * 256;
    float sum = 0.f, sq = 0.f;
    for (int i = 0; i < 32; ++i) {
      float f[8]; unpack8(*(const bf16x8*)(vr + i * 8), f);
#pragma unroll
      for (int e = 0; e < 8; ++e) { sum += f[e]; sq += f[e] * f[e]; }
    }
    sum += dpp_xor1(sum); sq += dpp_xor1(sq);
    const float mu = sum * (1.f / 512.f);
    const float var = fmaxf(sq * (1.f / 512.f) - mu * mu, 0.f);
    if (half == 0) { stats[tok * 2] = mu; stats[tok * 2 + 1] = rsqrtf(var + 1e-5f); }
  }
  __syncthreads();
  for (int g = 0; g < 4; ++g) {
    {
      const int q = tid & 127, hf = tid >> 7;
      const float mu = stats[q * 2], rs = stats[q * 2 + 1];
      const u16* vr = P + F_VA + (t0 + q) * 512 + g * 128 + hf * 64;
      const float* lg = p->sgu_ln_g + l * 512 + g * 128 + hf * 64;
      const float* lb = p->sgu_ln_b + l * 512 + g * 128 + hf * 64;
      for (int i = 0; i < 8; ++i) {
        float f[8]; unpack8(*(const bf16x8*)(vr + i * 8), f);
#pragma unroll
        for (int e = 0; e < 8; ++e) VnT[(hf * 64 + i * 8 + e) * 136 + q] = f2bf((f[e] - mu) * rs * lg[i * 8 + e] + lb[i * 8 + e]);
      }
    }
    __syncthreads();
    f32x4 acc[4][4]; zero_acc<4>(acc);
#pragma unroll
    for (int ks = 0; ks < 4; ++ks) {
      bf16x8 a[4], bb[4];
#pragma unroll
      for (int m = 0; m < 4; ++m) a[m] = *(const bf16x8*)(Wsb + (size_t)g * 16384 + (wr * 64 + m * 16 + l15) * 128 + ks * 32 + quad * 8);
#pragma unroll
      for (int n = 0; n < 4; ++n) bb[n] = *(const bf16x8*)(VnT + (wc * 64 + n * 16 + l15) * 136 + ks * 32 + quad * 8);
#pragma unroll
      for (int m = 0; m < 4; ++m)
#pragma unroll
        for (int n = 0; n < 4; ++n) acc[m][n] = mfma16(a[m], bb[n], acc[m][n]);
    }
    const float* bias = p->sgu_b + l * 512 + g * 128;
    u16* ua = P + F_UA + t0 * 512 + g * 128;
    {
      u16* Cs = (u16*)(smem + 128 * 136 * 2 + 1024);
      epi_foreach<4>(acc, [&](int r, int c, float v) { Cs[r * 136 + c] = f2bf(v + bias[r]); });
      __syncthreads();
#pragma unroll 2
      for (int i = 0; i < 8; ++i) {
        const int c = tid + i * 256, row = c >> 4, cc = (c & 15) * 8;
        u16* e = ua + (size_t)row * 512 + cc;
        float fu[8], fs[8];
        unpack8(*(const bf16x8*)e, fu); unpack8(*(const bf16x8*)(Cs + row * 136 + cc), fs);
#pragma unroll
        for (int k = 0; k < 8; ++k) fu[k] *= fs[k];
        *(bf16x8*)e = pack8(fu);
      }
    }
    __syncthreads();
  }
}

template <int RS>
DEV void scan_item(PPtr p, int l, int item, bool lat, unsigned char* smem) {
  float* sR = (float*)smem;
  float* sK = sR + 2048; float* sV = sK + 2048; float* sW = sV + 2048; float* sA = sW + 2048; float* sB = sA + 2048;
  float* sY = sB + 2048;
  u16* XW = (u16*)(sY + 2048);
  u16* XA = XW + 32 * 72;
  const u16* P = (const u16*)(p->ws + OFF_P);
  const u16* Wb = (const u16*)(p->ws + OFF_W);
  u16* Y = (u16*)(p->ws + OFF_Y);
  float* COEF = (float*)(p->ws + OFF_COEF);
  const int tid = tid_(), lane = tid & 63, wave = tid >> 6, l15 = lane & 15, quad = lane >> 4;
  constexpr int LPR = 4 * RS, KPL = 16 / RS, ROWS = 64 / RS, NV4 = KPL / 4, KP2 = KPL / 2;
  if (lat) __builtin_amdgcn_s_setprio(3);
  const int rpart = item % RS, sci = item / RS;
  const int b = sci >> 4, h = (sci >> 1) & 7, d = sci & 1;
  const int L = lat ? 2048 : 256;
  const size_t tbase = lat ? TCTX + (size_t)b * 2048 : (size_t)b * 256;
  const int v = rpart * ROWS + tid / LPR, kq = tid % LPR, key0 = kq * KPL;
  f32x2 S2[KP2];
  if (lat) {
    const float* s0 = p->state_wkv + ((((size_t)(b * 2 + l) * 2 + d) * 8 + h) * 64 + v) * 64 + key0;
#pragma unroll
    for (int i = 0; i < NV4; ++i) { float4 t4 = *(const float4*)(s0 + i * 4); S2[2 * i] = (f32x2){t4.x, t4.y}; S2[2 * i + 1] = (f32x2){t4.z, t4.w}; }
  } else {
#pragma unroll
    for (int i = 0; i < KP2; ++i) S2[i] = (f32x2){0.f, 0.f};
  }
  const float* mu = p->rwkv_mu + (size_t)(l * 2 + d) * 1664;
  const int sl = tid >> 3, part = tid & 7, ch0 = part * 8;
  float* sC = (float*)(XA + 32 * 72);
  __syncthreads();
  if (tid < 64) {
    sC[tid] = mu[h * 64 + tid]; sC[64 + tid] = mu[512 + h * 64 + tid]; sC[128 + tid] = mu[1024 + h * 64 + tid];
    sC[192 + tid] = mu[1536 + tid]; sC[256 + tid] = mu[1600 + tid];
    sC[320 + tid] = p->rwkv_k_k[l * 512 + h * 64 + tid]; sC[384 + tid] = p->rwkv_k_a[l * 512 + h * 64 + tid]; sC[448 + tid] = p->rwkv_r_k[l * 512 + h * 64 + tid];
  }
  __syncthreads();
  const int lm = wave & 1, ln0 = (wave >> 1) * 2;
  const u16* w2T = Wb + W_W2 + (size_t)d * 512 * 64 + (size_t)(h * 64) * 64;
  const u16* a2T = Wb + W_A2 + (size_t)d * 512 * 64 + (size_t)(h * 64) * 64;
  const float* w0 = p->rwkv_w0 + (size_t)(l * 2 + d) * 512 + h * 64;
  const float* a0 = p->rwkv_a0 + (size_t)(l * 2 + d) * 512 + h * 64;
  const int nch = L >> 5;
  bf16x8 q_r, q_k, q_v, q_w, q_a, n_r, n_k, n_v, n_w, n_a;
#define SCAN_FETCH(cc)                                                                                   \
  {                                                                                                      \
    const int s_ = (cc) * 32 + sl;                                                                       \
    const size_t t_ = tbase + (d ? (L - 1 - s_) : s_);                                                   \
    const size_t tn_ = (s_ > 0) ? (d ? t_ + 1 : t_ - 1) : t_;                                            \
    q_r = *(const bf16x8*)(P + F_RKV + t_ * 1536 + h * 64 + ch0);                                        \
    q_k = *(const bf16x8*)(P + F_RKV + t_ * 1536 + 512 + h * 64 + ch0);                                  \
    q_v = *(const bf16x8*)(P + F_RKV + t_ * 1536 + 1024 + h * 64 + ch0);                                 \
    q_w = *(const bf16x8*)(P + F_LORA + t_ * 256 + d * 128 + ch0);                                       \
    q_a = *(const bf16x8*)(P + F_LORA + t_ * 256 + d * 128 + 64 + ch0);                                  \
    n_r = *(const bf16x8*)(P + F_RKV + tn_ * 1536 + h * 64 + ch0);                                       \
    n_k = *(const bf16x8*)(P + F_RKV + tn_ * 1536 + 512 + h * 64 + ch0);                                 \
    n_v = *(const bf16x8*)(P + F_RKV + tn_ * 1536 + 1024 + h * 64 + ch0);                                \
    n_w = *(const bf16x8*)(P + F_LORA + tn_ * 256 + d * 128 + ch0);                                      \
    n_a = *(const bf16x8*)(P + F_LORA + tn_ * 256 + d * 128 + 64 + ch0);                                 \
  }
  SCAN_FETCH(0)
  bf16x8 bwf[2][2], baf[2][2];
#pragma unroll
  for (int ks = 0; ks < 2; ++ks)
#pragma unroll
    for (int n = 0; n < 2; ++n) {
      bwf[ks][n] = *(const bf16x8*)(w2T + (size_t)((ln0 + n) * 16 + l15) * 64 + ks * 32 + quad * 8);
      baf[ks][n] = *(const bf16x8*)(a2T + (size_t)((ln0 + n) * 16 + l15) * 64 + ks * 32 + quad * 8);
    }
  for (int c = 0; c < nch; ++c) {
    const int s = c * 32 + sl;
    const int pos = d ? (L - 1 - s) : s;
    const size_t t = tbase + pos;
    const bool hasnb = s > 0;
    float fr[8], fk[8], fv[8], fw[8], fa[8];
    {
      unpack8(q_r, fr); unpack8(q_k, fk); unpack8(q_v, fv); unpack8(q_w, fw); unpack8(q_a, fa);
      float nr[8], nk[8], nv[8], nw[8], na[8];
      unpack8(n_r, nr); unpack8(n_k, nk); unpack8(n_v, nv); unpack8(n_w, nw); unpack8(n_a, na);
      if (!hasnb) {
#pragma unroll
        for (int i = 0; i < 8; ++i) { nr[i] = 0.f; nk[i] = 0.f; nv[i] = 0.f; nw[i] = 0.f; na[i] = 0.f; }
      }
#pragma unroll
      for (int i = 0; i < 8; ++i) {
        fr[i] += sC[ch0 + i] * (nr[i] - fr[i]); fk[i] += sC[64 + ch0 + i] * (nk[i] - fk[i]); fv[i] += sC[128 + ch0 + i] * (nv[i] - fv[i]);
        fw[i] += sC[192 + ch0 + i] * (nw[i] - fw[i]); fa[i] += sC[256 + ch0 + i] * (na[i] - fa[i]);
      }
    }
    if (c + 1 < nch) SCAN_FETCH(c + 1)
    {
      float tw[8];
#pragma unroll
      for (int i = 0; i < 8; ++i) tw[i] = 1.f - 2.f * frcp(__expf(2.f * fw[i]) + 1.f);
      *(bf16x8*)(XW + sl * 72 + ch0) = pack8(tw);
      *(bf16x8*)(XA + sl * 72 + ch0) = pack8(fa);
#pragma unroll
      for (int i = 0; i < 8; ++i) { sR[sl * 64 + ch0 + i] = fr[i]; sV[sl * 64 + ch0 + i] = fv[i]; }
    }
    __syncthreads();
    {
      f32x4 aw[2], aa[2];
#pragma unroll
      for (int n = 0; n < 2; ++n) { aw[n] = (f32x4){0.f, 0.f, 0.f, 0.f}; aa[n] = (f32x4){0.f, 0.f, 0.f, 0.f}; }
#pragma unroll
      for (int ks = 0; ks < 2; ++ks) {
        bf16x8 xw = *(const bf16x8*)(XW + (lm * 16 + l15) * 72 + ks * 32 + quad * 8);
        bf16x8 xa = *(const bf16x8*)(XA + (lm * 16 + l15) * 72 + ks * 32 + quad * 8);
#pragma unroll
        for (int n = 0; n < 2; ++n) {
          aw[n] = mfma16(xw, bwf[ks][n], aw[n]);
          aa[n] = mfma16(xa, baf[ks][n], aa[n]);
        }
      }
#pragma unroll
      for (int n = 0; n < 2; ++n) {
        const int ch = (ln0 + n) * 16 + l15;
        const float w0c = w0[ch], a0c = a0[ch];
#pragma unroll
        for (int j = 0; j < 4; ++j) {
          const int row = lm * 16 + quad * 4 + j;
          const float z = w0c + aw[n][j];
          sW[row * 64 + ch] = __expf(-0.60653065971263342f * sigmoidf_(z));
          sA[row * 64 + ch] = sigmoidf_(a0c + aa[n][j]);
        }
      }
    }
    __syncthreads();
    {
      float av[8], kk[8], ssq = 0.f, cf = 0.f;
#pragma unroll
      for (int i = 0; i < 8; ++i) { av[i] = sA[sl * 64 + ch0 + i]; kk[i] = fk[i] * sC[320 + ch0 + i]; ssq += kk[i] * kk[i]; }
      ssq += dpp_xor1(ssq); ssq += dpp_xor2(ssq); ssq += dpp_hmirror(ssq);
      const float inv = rsqrtf(fmaxf(ssq, 1e-24f));
#pragma unroll
      for (int i = 0; i < 8; ++i) {
        const float kn = kk[i] * inv;
        const float km = fk[i] * (1.f + (av[i] - 1.f) * sC[384 + ch0 + i]);
        cf += fr[i] * km * sC[448 + ch0 + i];
        sK[sl * 64 + ch0 + i] = km;
        sA[sl * 64 + ch0 + i] = -kn;
        sB[sl * 64 + ch0 + i] = kn * av[i];
      }
      cf += dpp_xor1(cf); cf += dpp_xor2(cf); cf += dpp_hmirror(cf);
      if (part == 0 && rpart == 0) COEF[(t * 8 + h) * 2 + d] = cf;
    }
    __syncthreads();
    {
      f32x2 wA[KP2], kA[KP2], aA[KP2], bA[KP2], rA[KP2]; float vA;
      f32x2 wB[KP2], kB[KP2], aB[KP2], bB[KP2], rB[KP2]; float vB;
#define SCAN_LOAD(W_, K_, A_, B_, R_, V_, st_)                                                                              \
  {                                                                                                                       \
    _Pragma("unroll") for (int i = 0; i < NV4; ++i) {                                                                     \
      float4 t4;                                                                                                          \
      t4 = *(const float4*)(sW + (st_) * 64 + key0 + i * 4); W_[2 * i] = (f32x2){t4.x, t4.y}; W_[2 * i + 1] = (f32x2){t4.z, t4.w}; \
      t4 = *(const float4*)(sK + (st_) * 64 + key0 + i * 4); K_[2 * i] = (f32x2){t4.x, t4.y}; K_[2 * i + 1] = (f32x2){t4.z, t4.w}; \
      t4 = *(const float4*)(sA + (st_) * 64 + key0 + i * 4); A_[2 * i] = (f32x2){t4.x, t4.y}; A_[2 * i + 1] = (f32x2){t4.z, t4.w}; \
      t4 = *(const float4*)(sB + (st_) * 64 + key0 + i * 4); B_[2 * i] = (f32x2){t4.x, t4.y}; B_[2 * i + 1] = (f32x2){t4.z, t4.w}; \
      t4 = *(const float4*)(sR + (st_) * 64 + key0 + i * 4); R_[2 * i] = (f32x2){t4.x, t4.y}; R_[2 * i + 1] = (f32x2){t4.z, t4.w}; \
    }                                                                                                                     \
    V_ = sV[(st_) * 64 + v];                                                                                              \
  }
#define SCAN_STEP(W_, K_, A_, B_, R_, V_, st_)                                                                              \
  {                                                                                                                       \
    f32x2 sacc = S2[0] * A_[0];                                                                                           \
    _Pragma("unroll") for (int i = 1; i < KP2; ++i) sacc = __builtin_elementwise_fma(S2[i], A_[i], sacc);                 \
    const f32x2 vv = {V_, V_};                                                                                            \
    f32x2 vk[KP2];                                                                                                        \
    _Pragma("unroll") for (int i = 0; i < KP2; ++i) vk[i] = vv * K_[i];                                                   \
    float sa = sacc.x + sacc.y;                                                                                           \
    sa += dpp_xor1(sa); sa += dpp_xor2(sa);                                                                               \
    if (LPR >= 8) sa += dpp_hmirror(sa);                                                                                  \
    if (LPR >= 16) sa += dpp_mirror(sa);                                                                                  \
    const f32x2 sav = {sa, sa};                                                                                           \
    f32x2 yacc = {0.f, 0.f};                                                                                              \
    _Pragma("unroll") for (int i = 0; i < KP2; ++i) {                                                                     \
      const f32x2 t = __builtin_elementwise_fma(sav, B_[i], vk[i]);                                                       \
      S2[i] = __builtin_elementwise_fma(S2[i], W_[i], t);                                                                 \
      yacc = __builtin_elementwise_fma(S2[i], R_[i], yacc);                                                               \
    }                                                                                                                     \
    float y = yacc.x + yacc.y;                                                                                            \
    y += dpp_xor1(y); y += dpp_xor2(y);                                                                                   \
    if (LPR >= 8) y += dpp_hmirror(y);                                                                                    \
    if (LPR >= 16) y += dpp_mirror(y);                                                                                    \
    sY[(st_) * 64 + v] = y;                                                                                               \
  }
      SCAN_LOAD(wA, kA, aA, bA, rA, vA, 0)
#pragma unroll 1
      for (int st = 0; st < 32; st += 2) {
        SCAN_LOAD(wB, kB, aB, bB, rB, vB, st + 1)
        SCAN_STEP(wA, kA, aA, bA, rA, vA, st)
        if (st + 2 < 32) SCAN_LOAD(wA, kA, aA, bA, rA, vA, st + 2)
        SCAN_STEP(wB, kB, aB, bB, rB, vB, st + 1)
      }
#undef SCAN_LOAD
#undef SCAN_STEP
    }
    __syncthreads();
    {
      float yv[8];
#pragma unroll
      for (int i = 0; i < 8; ++i) yv[i] = sY[sl * 64 + ch0 + i];
      if (ch0 >= rpart * ROWS && ch0 < (rpart + 1) * ROWS) *(bf16x8*)(Y + (size_t)d * TT * 512 + t * 512 + h * 64 + ch0) = pack8(yv);
    }
#undef SCAN_FETCH_DUMMY
  }
  __builtin_amdgcn_s_setprio(0);
  if (!lat) {
    float* dst = p->out + O_NST + ((((size_t)(b * 2 + l) * 2 + d) * 8 + h) * 64 + v) * 64 + key0;
#pragma unroll
    for (int i = 0; i < NV4; ++i) *(float4*)(dst + i * 4) = make_float4(S2[2 * i].x, S2[2 * i].y, S2[2 * i + 1].x, S2[2 * i + 1].y);
  }
  __syncthreads();
}

constexpr int SCAN_RS = 2;
constexpr int MIX_LS = 128 * SCAN_RS, MIX_CS = 512 * SCAN_RS, MIX_LA = 1024, MIX_SG = 192, MIX_CA = 512;
constexpr int MIX_B = MIX_LA + MIX_CS + MIX_SG + MIX_CA;
constexpr size_t OFF_CUTAB = 458752;

DEV void phase_mix(PPtr p, int l, unsigned char* smem) {
  unsigned* ctrA = (unsigned*)(p->ws + OFF_CTR) + l * 2;
  unsigned* ctrB = ctrA + 1;
  int* slot = (int*)(smem + SMEM_BYTES - 16);
  const int tidm = tid_();
  __syncthreads();
  if (tidm == 0) {
    const unsigned hw = __builtin_amdgcn_s_getreg((31 << 11) | 4), xcc = __builtin_amdgcn_s_getreg((3 << 11) | 20);
    const unsigned key = ((xcc & 15u) << 8) | ((hw >> 8) & 255u);
    slot[1] = (int)atomicAdd((unsigned*)(p->ws + OFF_CUTAB) + l * 4096 + key, 1u);
  }
  __syncthreads();
  const bool primary = slot[1] == 0;
  bool a_open = true, b_open = true;
  for (;;) {
    __syncthreads();
    if (tidm == 0) {
      int it = -1;
      if (primary) {
        if (a_open) { it = (int)atomicAdd(ctrA, 1u); if (it >= MIX_LS) { a_open = false; it = -1; } }
        if (it < 0 && b_open) { it = (int)atomicAdd(ctrB, 1u); if (it >= MIX_B) { b_open = false; it = -1; } else it += MIX_LS; }
      } else {
        if (b_open) { it = (int)atomicAdd(ctrB, 1u); if (it >= MIX_B) { b_open = false; it = -1; } else it += MIX_LS; }
        if (it < 0 && a_open) { it = (int)atomicAdd(ctrA, 1u); if (it >= MIX_LS) { a_open = false; it = -1; } }
      }
      *slot = it;
    }
    __syncthreads();
    int item = *slot;
    if (item < 0) break;
    if (item < MIX_LS) scan_item<SCAN_RS>(p, l, item, true, smem);
    else if ((item -= MIX_LS) < MIX_LA) attn_item(p, item, true, smem);
    else if ((item -= MIX_LA) < MIX_CS) scan_item<SCAN_RS>(p, l, item, false, smem);
    else if ((item -= MIX_CS) < MIX_SG) sgu_item(p, l, item, smem);
    else attn_item(p, item - MIX_SG, false, smem);
  }
}

DEV void phase_fin(PPtr p, int l, unsigned char* smem) {
  u16* As = (u16*)smem; u16* Bs = As + 128 * 72; u16* Zs = Bs + 128 * 72;
  const u16* P = (const u16*)(p->ws + OFF_P);
  const u16* W = (const u16*)(p->ws + OFF_W);
  u16* Y = (u16*)(p->ws + OFF_Y);
  const float* COEF = (const float*)(p->ws + OFF_COEF);
  const int tid = tid_();
  for (int id = vblock(); id < 384 * 4; id += gridDim.x) {
    int mt, nt; tile_map(id, 4, mt, nt);
    const int m0 = mt * 64, c0 = nt * 128;
    __syncthreads();
    for (int it = 0; it < 4; ++it) {
      const int slot = it * 256 + tid, pair = slot >> 3, sub = slot & 7;
      const int tok = pair >> 1, hd = pair & 1;
      const int ch = c0 + hd * 64 + sub * 8, head = nt * 2 + hd;
      const size_t t = (size_t)m0 + tok;
      const bool lat = t >= TCTX;
      const int pos = lat ? (int)((t - TCTX) & 2047) : (int)(t & 255);
      const int L = lat ? 2048 : 256;
      float y0[8], y1[8];
      unpack8(*(const bf16x8*)(Y + t * 512 + ch), y0);
      unpack8(*(const bf16x8*)(Y + (size_t)TT * 512 + t * 512 + ch), y1);
      float sum = 0.f;
#pragma unroll
      for (int i = 0; i < 8; ++i) { y0[i] += y1[i]; sum += y0[i]; }
      sum += dpp_xor1(sum); sum += dpp_xor2(sum); sum += dpp_hmirror(sum);
      const float mu = sum * (1.f / 64.f);
      float sq = 0.f;
#pragma unroll
      for (int i = 0; i < 8; ++i) { y0[i] -= mu; sq += y0[i] * y0[i]; }
      sq += dpp_xor1(sq); sq += dpp_xor2(sq); sq += dpp_hmirror(sq);
      const float rs = rsqrtf(sq * (1.f / 64.f) + GN_EPS);
      float vv[8], n0v[8], n1v[8];
      unpack8(*(const bf16x8*)(P + F_RKV + t * 1536 + 1024 + ch), vv);
      if (pos > 0) unpack8(*(const bf16x8*)(P + F_RKV + (t - 1) * 1536 + 1024 + ch), n0v);
      else {
#pragma unroll
        for (int i = 0; i < 8; ++i) n0v[i] = 0.f;
      }
      if (pos < L - 1) unpack8(*(const bf16x8*)(P + F_RKV + (t + 1) * 1536 + 1024 + ch), n1v);
      else {
#pragma unroll
        for (int i = 0; i < 8; ++i) n1v[i] = 0.f;
      }
      const float cf0 = COEF[(t * 8 + head) * 2], cf1 = COEF[(t * 8 + head) * 2 + 1];
      const float* mu0 = p->rwkv_mu + (size_t)(l * 2) * 1664 + 1024 + ch;
      const float* mu1 = p->rwkv_mu + (size_t)(l * 2 + 1) * 1664 + 1024 + ch;
      const float* lg = p->rwkv_lnx_g + l * 512 + ch;
      const float* lb = p->rwkv_lnx_b + l * 512 + ch;
      float z[8];
#pragma unroll
      for (int i = 0; i < 8; ++i) {
        const float vs0 = vv[i] + mu0[i] * (n0v[i] - vv[i]);
        const float vs1 = vv[i] + mu1[i] * (n1v[i] - vv[i]);
        z[i] = y0[i] * rs * lg[i] + lb[i] + cf0 * vs0 + cf1 * vs1;
      }
      *(bf16x8*)(Zs + tok * 136 + hd * 64 + sub * 8) = pack8(z);
    }
    ASig al{P + F_GD + (size_t)m0 * 128, 128};
    f32x4 acc[2][4]; zero_acc<2>(acc);
    gemm_mainloop<2>(acc, al, W + W_G2 + (size_t)c0 * 128, 128, 128, As, Bs);
    u16* dst = Y + (size_t)m0 * 512 + c0;
    epi_bf16<2>(acc, As, dst, 512, [&](int r, int c, float v) { return v * bf2f(Zs[r * 136 + c]); });
    {
      const float* xr0 = (l == 0) ? (m0 < TCTX ? p->x_prompt + (size_t)m0 * 1024 : p->x_sample + (size_t)(m0 - TCTX) * 1024) : p->out + (size_t)m0 * 1024;
      const float* mod = (const float*)(p->ws + OFF_MOD) + (size_t)(l * 9 + cv_of(m0)) * 6144;
      u16* Pw = (u16*)(p->ws + OFF_P);
#pragma unroll 4
      for (int i = 0; i < 8; ++i) {
        const int c = tid + i * 256, row = c >> 5, cc = c & 31;
        const int hcol = (cc < 16) ? c0 + cc * 8 : 512 + c0 + (cc - 16) * 8;
        bf16x8 hv;
        if (l == 0) { AModX al{xr0, mod + 1024, mod}; hv = al(row, hcol); }
        else {
          const float2 ms = *(const float2*)((const float*)(p->ws + OFF_ST) + (size_t)TT * 2 + ((size_t)m0 + row) * 2);
          const float* xr = xr0 + (size_t)row * 1024 + hcol;
          const float* lg = p->ln2_g + hcol; const float* lb = p->ln2_b + hcol;
          float f[8];
#pragma unroll
          for (int e = 0; e < 8; ++e) {
            const float xv = (xr[e] - ms.x) * ms.y * lg[e] + lb[e];
            f[e] = xv * (1.f + mod[1024 + hcol + e]) + mod[hcol + e];
          }
          hv = pack8(f);
        }
        u16* d = (cc < 16) ? Pw + F_VA + ((size_t)m0 + row) * 512 + c0 + cc * 8 : Y + (size_t)TT * 512 + ((size_t)m0 + row) * 512 + c0 + (cc - 16) * 8;
        *(bf16x8*)d = hv;
      }
    }
  }
}

DEV void phase_merge1(PPtr p, int l, unsigned char* smem) {
  u16* Ct = (u16*)(smem + 32768);
  u16* P = (u16*)(p->ws + OFF_P);
  const u16* W = (const u16*)(p->ws + OFF_W);
  const u16* Y = (const u16*)(p->ws + OFF_Y);
  const u16* HLO = P + F_VA;
  const u16* HHI = Y + (size_t)TT * 512;
  u16* MIX = P + F_RKV;
  TQ tq{(unsigned*)(p->ws + OFF_GQ) + (l * 5 + 1) * 128, 192 * 8, xcc_id(), 0};
  int* slot = (int*)(smem + SMEM_BYTES - 16);
  const int tidq = tid_();
  bool pre = false;
  int id = tq_pull(tq, slot, tidq);
  while (id >= 0) {
    int mt, nt; tile_map(id, 8, mt, nt);
    const int m0 = mt * 128, n0 = nt * 128;
    const int idn = tq_pull(tq, slot, tidq); const bool hn = idn >= 0;
    int mtn = 0, ntn = 0; if (hn) tile_map(idn, 8, mtn, ntn);
    f32x4 mix[4][4]; zero_acc<4>(mix);
#pragma unroll 1
    for (int j = 0; j < 3; ++j) {
      const u16* br = ((j == 0) ? P + F_UA : (j == 1) ? P + F_Q : Y) + (size_t)m0 * 512;
      const u16* wb = W + W_BR + ((size_t)j * 1024 + n0) * 512;
      unsigned sg[4][4][2];
      {
        f32x4 accG[4][4]; zero_acc<4>(accG);
        const u16* wg = W + W_IN + ((size_t)3712 + j * 1024 + n0) * 1024;
        gemm_mainloop_dma<4>(accG, HLO + (size_t)m0 * 512, 512, wg, 1024, 512, smem, pre || j > 0, HHI + (size_t)m0 * 512, 512, wg + 512, 1024);
        gemm_mainloop_dma<4>(accG, HHI + (size_t)m0 * 512, 512, wg + 512, 1024, 512, smem, true, br, 512, wb, 512);
#pragma unroll
        for (int m = 0; m < 4; ++m)
#pragma unroll
          for (int n = 0; n < 4; ++n) {
            sg[m][n][0] = pk2(sigmoidf_(accG[m][n][0]), sigmoidf_(accG[m][n][1]));
            sg[m][n][1] = pk2(sigmoidf_(accG[m][n][2]), sigmoidf_(accG[m][n][3]));
          }
      }
      const u16* nA; const u16* nB;
      if (j < 2) { nA = HLO + (size_t)m0 * 512; nB = W + W_IN + ((size_t)3712 + (j + 1) * 1024 + n0) * 1024; }
      else { nA = hn ? HLO + (size_t)mtn * 128 * 512 : nullptr; nB = W + W_IN + ((size_t)3712 + ntn * 128) * 1024; }
      f32x4 accP[4][4]; zero_acc<4>(accP);
      gemm_mainloop_dma<4, false>(accP, br, 512, wb, 512, 512, smem, true, nA, 512, nB, 1024);
#pragma unroll
      for (int m = 0; m < 4; ++m)
#pragma unroll
        for (int n = 0; n < 4; ++n) {
          mix[m][n][0] += __uint_as_float(sg[m][n][0] << 16) * accP[m][n][0];
          mix[m][n][1] += __uint_as_float(sg[m][n][0] & 0xffff0000u) * accP[m][n][1];
          mix[m][n][2] += __uint_as_float(sg[m][n][1] << 16) * accP[m][n][2];
          mix[m][n][3] += __uint_as_float(sg[m][n][1] & 0xffff0000u) * accP[m][n][3];
        }
    }
    pre = hn;
    u16* dst = MIX + (size_t)m0 * 1024 + n0;
    epi_bf16<4>(mix, Ct, dst, 1024, [](int, int, float v) { return v; });
    id = idn;
  }
}

DEV void phase_merge2(PPtr p, int l, unsigned char* smem) {
  const u16* P = (const u16*)(p->ws + OFF_P);
  const u16* W = (const u16*)(p->ws + OFF_W);
  const float* MOD = (const float*)(p->ws + OFF_MOD);
  const u16* MIX = P + F_RKV;
  TQ tq{(unsigned*)(p->ws + OFF_GQ) + (l * 5 + 2) * 128, 192 * 8, xcc_id(), 0};
  int* slot = (int*)(smem + SMEM_BYTES - 16);
  const int tidq = tid_();
  bool pre = false;
  int id = tq_pull(tq, slot, tidq);
  while (id >= 0) {
    int mt, nt; tile_map(id, 8, mt, nt);
    const int m0 = mt * 128, n0 = nt * 128;
    const int idn = tq_pull(tq, slot, tidq); const bool hn = idn >= 0;
    int mtn = 0, ntn = 0; if (hn) tile_map(idn, 8, mtn, ntn);
    const float* xrow0 = (l == 0) ? (m0 < TCTX ? p->x_prompt + (size_t)m0 * 1024 : p->x_sample + (size_t)(m0 - TCTX) * 1024) : p->out + (size_t)m0 * 1024;
    const float* g1 = MOD + (size_t)(l * 9 + cv_of(m0)) * 6144 + 2048 + n0;
    f32x4 acc[4][4]; zero_acc<4>(acc);
    gemm_mainloop_dma<4>(acc, MIX + (size_t)m0 * 1024, 1024, W + W_OUT + (size_t)n0 * 1024, 1024, 1024, smem, pre,
                         hn ? MIX + (size_t)mtn * 128 * 1024 : nullptr, 1024, W + W_OUT + (size_t)ntn * 128 * 1024, 1024);
    pre = hn;
    float* dst = p->out + (size_t)m0 * 1024 + n0;
    const float* xs = xrow0 + n0;
    const float* st2 = (const float*)(p->ws + OFF_ST) + (size_t)TT * 2 + (size_t)m0 * 2;
    const float* lng = p->ln2_g + n0; const float* lnb = p->ln2_b + n0;
    epi_f32(acc, (float*)(smem + 32768), [&](int r, int c, float4 a) {
      float4 x4 = *(const float4*)(xs + (size_t)r * 1024 + c);
      const float4 g4 = *(const float4*)(g1 + c);
      if (l == 1) {
        const float2 ms = *(const float2*)(st2 + r * 2);
        const float4 lg = *(const float4*)(lng + c), lb = *(const float4*)(lnb + c);
        x4 = make_float4((x4.x - ms.x) * ms.y * lg.x + lb.x, (x4.y - ms.x) * ms.y * lg.y + lb.y, (x4.z - ms.x) * ms.y * lg.z + lb.z, (x4.w - ms.x) * ms.y * lg.w + lb.w);
      }
      *(float4*)(dst + (size_t)r * 1024 + c) = make_float4(ALPHA * x4.x + g4.x * a.x, ALPHA * x4.y + g4.y * a.y, ALPHA * x4.z + g4.z * a.z, ALPHA * x4.w + g4.w * a.w);
    });
    id = idn;
  }
}

DEV void phase_ln(PPtr p, const float* g, const float* bta, const float* modl, int sc_off, int sh_off, float* stats) {
  const int tid = tid_(); const int lane = tid & 63, wave = tid >> 6;
  float4 nv[4];
  {
    const float* r0 = p->out + (size_t)(blockIdx.x * 4 + wave) * 1024;
#pragma unroll
    for (int i = 0; i < 4; ++i) nv[i] = *(const float4*)(r0 + (i * 64 + lane) * 4);
  }
  for (int u = blockIdx.x; u < TT / 4; u += gridDim.x) {
    float* row = p->out + (size_t)(u * 4 + wave) * 1024;
    float4 v[4];
    float sum = 0.f;
#pragma unroll
    for (int i = 0; i < 4; ++i) { v[i] = nv[i]; sum += v[i].x + v[i].y + v[i].z + v[i].w; }
    if (u + (int)gridDim.x < TT / 4) {
      const float* rn = row + (size_t)gridDim.x * 4 * 1024;
#pragma unroll
      for (int i = 0; i < 4; ++i) nv[i] = *(const float4*)(rn + (i * 64 + lane) * 4);
    }
    sum = wave_sum(sum, lane);
    const float mu = sum * (1.f / 1024.f);
    float sq = 0.f;
#pragma unroll
    for (int i = 0; i < 4; ++i) {
      v[i].x -= mu; v[i].y -= mu; v[i].z -= mu; v[i].w -= mu;
      sq += v[i].x * v[i].x + v[i].y * v[i].y + v[i].z * v[i].z + v[i].w * v[i].w;
    }
    sq = wave_sum(sq, lane);
    const float rs = rsqrtf(sq * (1.f / 1024.f) + 1e-5f);
    if (stats && lane == 0) *(float2*)(stats + (size_t)(u * 4 + wave) * 2) = make_float2(mu, rs);
#pragma unroll
    for (int i = 0; i < 4; ++i) {
      const int c = (i * 64 + lane) * 4;
      float4 gg = *(const float4*)(g + c), bb = *(const float4*)(bta + c);
      float4 o4 = make_float4(v[i].x * rs * gg.x + bb.x, v[i].y * rs * gg.y + bb.y, v[i].z * rs * gg.z + bb.z, v[i].w * rs * gg.w + bb.w);
      if (!stats) *(float4*)(row + c) = o4;
      if (modl) {
        const float* mrow = modl + (size_t)cv_of(u * 4 + wave) * 6144;
        const float4 s4 = *(const float4*)(mrow + sc_off + c), h4 = *(const float4*)(mrow + sh_off + c);
        uint2 hv;
        hv.x = pk2(o4.x * (1.f + s4.x) + h4.x, o4.y * (1.f + s4.y) + h4.y);
        hv.y = pk2(o4.z * (1.f + s4.z) + h4.z, o4.w * (1.f + s4.w) + h4.w);
        *(uint2*)((u16*)(p->ws + OFF_H) + (size_t)(u * 4 + wave) * 1024 + c) = hv;
      }
    }
  }
}

DEV void phase_ffn1(PPtr p, int l, unsigned char* smem) {
  u16* Ct = (u16*)(smem + 32768);
  const u16* W = (const u16*)(p->ws + OFF_W);
  const u16* H = (const u16*)(p->ws + OFF_H);
  u16* HID = (u16*)(p->ws + OFF_HID);
  TQ tq{(unsigned*)(p->ws + OFF_GQ) + (l * 5 + 3) * 128, 192 * 32, xcc_id(), 0};
  int* slot = (int*)(smem + SMEM_BYTES - 16);
  const int tidq = tid_();
  bool pre = false;
  int id = tq_pull(tq, slot, tidq);
  while (id >= 0) {
    int mt, nt; tile_map(id, 32, mt, nt);
    const int m0 = mt * 128, n0 = nt * 128;
    const int idn = tq_pull(tq, slot, tidq); const bool hn = idn >= 0;
    int mtn = 0, ntn = 0; if (hn) tile_map(idn, 32, mtn, ntn);
    f32x4 acc[4][4]; zero_acc<4>(acc);
    gemm_mainloop_dma<4>(acc, H + (size_t)m0 * 1024, 1024, W + W_UP + (size_t)n0 * 1024, 1024, 1024, smem, pre,
                         hn ? H + (size_t)mtn * 128 * 1024 : nullptr, 1024, W + W_UP + (size_t)ntn * 128 * 1024, 1024);
    pre = hn;
    u16* dst = HID + (size_t)m0 * 4096 + n0;
    epi_bf16<4>(acc, Ct, dst, 4096, [](int, int, float v) { float q = fmaxf(v, 0.f); return q * q; });
    id = idn;
  }
}

DEV void phase_ffn2(PPtr p, int l, unsigned char* smem) {
  const u16* W = (const u16*)(p->ws + OFF_W);
  const float* MOD = (const float*)(p->ws + OFF_MOD);
  const u16* HID = (const u16*)(p->ws + OFF_HID);
  TQ tq{(unsigned*)(p->ws + OFF_GQ) + (l * 5 + 4) * 128, 192 * 8, xcc_id(), 0};
  int* slot = (int*)(smem + SMEM_BYTES - 16);
  const int tidq = tid_();
  bool pre = false;
  int id = tq_pull(tq, slot, tidq);
  while (id >= 0) {
    int mt, nt; tile_map(id, 8, mt, nt);
    const int m0 = mt * 128, n0 = nt * 128;
    const int idn = tq_pull(tq, slot, tidq); const bool hn = idn >= 0;
    int mtn = 0, ntn = 0; if (hn) tile_map(idn, 8, mtn, ntn);
    const float* g2 = MOD + (size_t)(l * 9 + cv_of(m0)) * 6144 + 5120 + n0;
    f32x4 acc[4][4]; zero_acc<4>(acc);
    gemm_mainloop_dma<4>(acc, HID + (size_t)m0 * 4096, 4096, W + W_DOWN + (size_t)n0 * 4096, 4096, 4096, smem, pre,
                         hn ? HID + (size_t)mtn * 128 * 4096 : nullptr, 4096, W + W_DOWN + (size_t)ntn * 128 * 4096, 4096);
    pre = hn;
    float* dst = p->out + (size_t)m0 * 1024 + n0;
    const float* st1 = (const float*)(p->ws + OFF_ST) + (size_t)m0 * 2;
    const float* lng = p->ln1_g + l * 1024 + n0; const float* lnb = p->ln1_b + l * 1024 + n0;
    epi_f32(acc, (float*)(smem + 32768), [&](int r, int c, float4 a) {
      float* e = dst + (size_t)r * 1024 + c;
      const float2 ms = *(const float2*)(st1 + r * 2);
      const float4 y4 = *(const float4*)e, g4 = *(const float4*)(g2 + c), lg = *(const float4*)(lng + c), lb = *(const float4*)(lnb + c);
      const float4 x4 = make_float4((y4.x - ms.x) * ms.y * lg.x + lb.x, (y4.y - ms.x) * ms.y * lg.y + lb.y, (y4.z - ms.x) * ms.y * lg.z + lb.z, (y4.w - ms.x) * ms.y * lg.w + lb.w);
      *(float4*)e = make_float4(ALPHA * x4.x + g4.x * a.x, ALPHA * x4.y + g4.y * a.y, ALPHA * x4.z + g4.z * a.z, ALPHA * x4.w + g4.w * a.w);
    });
    id = idn;
  }
}

__global__ void __launch_bounds__(NTHR, 2) fwd_megakernel(Params p_unused) {
  __shared__ __attribute__((aligned(16))) unsigned char smem[SMEM_BYTES];
  cg::grid_group grid = cg::this_grid();
  PPtr kp = (PPtr)__builtin_amdgcn_kernarg_segment_ptr();
#define p launder_p(kp)
  {
    unsigned* st0 = (unsigned*)(smem + SMEM_BYTES - 8);
    if (tid_() == 0) {
      st0[0] = 0u; st0[1] = 0u;
      const unsigned x = (unsigned)__builtin_amdgcn_s_getreg((3 << 11) | 20) & 0xFu;
      (void)xb_add((unsigned*)(p->ws + OFF_XB) + XB_XCNT(x), 1u);
    }
    __syncthreads();
  }
#define MODP ((const float*)(p->ws + OFF_MOD))
#pragma unroll 1
  for (int step = 0; step < 21; ++step) {
    const int l = (step - 1) / 10, ph = (step - 1) % 10;
    if (step == 0) {
      for (int u = blockIdx.x; u < 192; u += gridDim.x) mod_unit(p, u, (float*)smem);
      if (p->ws == nullptr) grid.sync();
    } else if (ph == 0) { if (l == 0) phase_convert(p, 0, smem); else continue; }
    else if (ph == 1) phase_inproj(p, l, smem);
    else if (ph == 2) phase_mix(p, l, smem);
    else if (ph == 3) phase_fin(p, l, smem);
    else if (ph == 4) phase_merge1(p, l, smem);
    else if (ph == 5) phase_merge2(p, l, smem);
    else if (ph == 6) phase_ln(p, p->ln1_g + l * 1024, p->ln1_b + l * 1024, MODP + (size_t)l * 9 * 6144, 4096, 3072, (float*)(p->ws + OFF_ST));
    else if (ph == 7) phase_ffn1(p, l, smem);
    else if (ph == 8) phase_ffn2(p, l, smem);
    else {
      phase_ln(p, p->ln2_g + l * 1024, p->ln2_b + l * 1024, l == 0 ? MODP + (size_t)9 * 6144 : nullptr, 1024, 0, l == 0 ? (float*)(p->ws + OFF_ST) + (size_t)TT * 2 : nullptr);
      if (l == 0) phase_convert(p, 1, smem); else break;
    }
    gbar((unsigned*)(p->ws + OFF_XB), smem);
  }
}
#undef MODP
#undef p

extern "C" void kernel_launch(void* const* d_in, const int* in_sizes, int n_in, void* d_out, int out_size, void* d_ws,
                              size_t ws_size, hipStream_t stream) {
  static int grid_blocks = 0;
  if (!grid_blocks) {
    if (n_in != 35 || ws_size < WS_END) { fprintf(stderr, "kernel_launch: bad n_in %d or ws %zu < %zu\n", n_in, ws_size, (size_t)WS_END); grid_blocks = -1; return; }
    int dev = 0, cus = 0, per_cu = 0;
    hipGetDevice(&dev);
    hipDeviceGetAttribute(&cus, hipDeviceAttributeMultiprocessorCount, dev);
    hipOccupancyMaxActiveBlocksPerMultiprocessor(&per_cu, fwd_megakernel, NTHR, 0);
    if (per_cu > 2) per_cu = 2;
    if (per_cu < 1) per_cu = 1;
    grid_blocks = cus * per_cu;
  }
  if (grid_blocks < 0) return;
  hipMemsetAsync((unsigned char*)d_ws + OFF_CUTAB, 0, 65536, stream);
  Params p{};
  const float** pp = (const float**)&p;
  for (int i = 0; i < 35; ++i) pp[i] = (const float*)d_in[i];
  p.out = (float*)d_out;
  p.ws = (unsigned char*)d_ws;
  void* args[] = {&p};
  hipError_t e = hipLaunchCooperativeKernel((void*)fwd_megakernel, dim3(grid_blocks), dim3(NTHR), args, 0, stream);
  if (e != hipSuccess) fprintf(stderr, "cooperative launch failed: %s (grid %d)\n", hipGetErrorString(e), grid_blocks);
}
```

```cpp
#include <hip/hip_runtime.h>
#include <hip/hip_cooperative_groups.h>
#include <cstdio>
namespace cg = cooperative_groups;

typedef unsigned short u16;
typedef __attribute__((ext_vector_type(8))) short bf16x8;
typedef __attribute__((ext_vector_type(4))) short bf16x4;
typedef __attribute__((ext_vector_type(4))) float f32x4;

#define DEV __device__ __forceinline__

constexpr int TCTX = 8192, TLAT = 16384, TT = 24576;
constexpr float ALPHA = 1.41421356237309515f;
constexpr float GN_EPS = 64e-5f;
constexpr int NTHR = 256;

constexpr size_t OFF_MOD = 0;
constexpr size_t OFF_COEF = 524288;
constexpr size_t OFF_CTR = 516096;
constexpr size_t OFF_W = 2101248;
constexpr size_t W_UP = 0, W_DOWN = 4194304, W_IN = 8388608, W_BR = 15335424, W_OUT = 16908288,
                 W_SGU = 17956864, W_W2 = 18022400, W_A2 = 18087936, W_G2 = 18153472, W_TOTAL = 18219008;
constexpr size_t OFF_KC = OFF_W + W_TOTAL * 2;
constexpr size_t KC_LAT = 1048576;
constexpr size_t KC_ELEMS = 3670016;
constexpr size_t OFF_VT = OFF_KC + KC_ELEMS * 2;
constexpr size_t OFF_P = OFF_VT + KC_ELEMS * 2;
constexpr size_t F_UA = 0, F_VA = 12582912, F_Q = 25165824, F_KK = 37748736, F_VV = 40894464, F_RKV = 44040192,
                 F_LORA = 81788928, F_GD = 88080384, P_ELEMS = 91226112;
constexpr size_t OFF_Y = OFF_P + P_ELEMS * 2;
constexpr size_t Y_ELEMS = 25165824;
constexpr size_t OFF_ST = OFF_Y + Y_ELEMS * 2;
constexpr size_t WS_END = OFF_ST + (size_t)2 * TT * 2 * 4;
constexpr size_t OFF_HID = OFF_W + W_IN * 2;
constexpr size_t OFF_H = OFF_Y;
static_assert(OFF_HID + (size_t)TT * 4096 * 2 <= OFF_Y, "HID overlaps H");
constexpr size_t O_NCK = 25165824, O_NCV = 27262976, O_NST = 29360128;

constexpr int SMEM_BYTES = 73728;

struct Params {
  const float *x_prompt, *x_sample, *cache_k, *cache_v, *state_wkv, *c, *c_ctx, *w_ada, *b_ada, *w_in,
      *sgu_ln_g, *sgu_ln_b, *sgu_w, *sgu_b, *q_norm, *k_norm, *rwkv_mu, *rwkv_w0, *rwkv_w2, *rwkv_a0, *rwkv_a2,
      *rwkv_k_k, *rwkv_k_a, *rwkv_r_k, *rwkv_g2, *rwkv_lnx_g, *rwkv_lnx_b, *w_branch, *w_out, *ln1_g, *ln1_b,
      *w_up, *w_down, *ln2_g, *ln2_b;
  float* out;
  unsigned char* ws;
};

typedef __attribute__((ext_vector_type(2))) float f32x2;
typedef __attribute__((ext_vector_type(2))) __bf16 bf16x2_t;
typedef __attribute__((ext_vector_type(4))) unsigned u32x4;
DEV unsigned pk2(float a, float b) { f32x2 v = {a, b}; return __builtin_bit_cast(unsigned, __builtin_convertvector(v, bf16x2_t)); }
DEV u16 f2bf(float f) { return (u16)(pk2(f, 0.f) & 0xffffu); }
DEV float bf2f(u16 h) { return __uint_as_float(((unsigned)h) << 16); }
DEV float bfs(short h) { return __uint_as_float(((unsigned)(u16)h) << 16); }
DEV float frcp(float x) { return __builtin_amdgcn_rcpf(x); }
DEV float sigmoidf_(float x) { return frcp(1.f + __expf(-x)); }
DEV bf16x8 pack8(const float* f) {
  u32x4 r = {pk2(f[0], f[1]), pk2(f[2], f[3]), pk2(f[4], f[5]), pk2(f[6], f[7])};
  return __builtin_bit_cast(bf16x8, r);
}
DEV void unpack8(bf16x8 v, float* f) {
#pragma unroll
  for (int i = 0; i < 8; ++i) f[i] = bfs(v[i]);
}
DEV float dpp_xor1(float x) { return __int_as_float(__builtin_amdgcn_update_dpp(0, __float_as_int(x), 0xB1, 0xF, 0xF, true)); }
DEV float dpp_xor2(float x) { return __int_as_float(__builtin_amdgcn_update_dpp(0, __float_as_int(x), 0x4E, 0xF, 0xF, true)); }
DEV float dpp_hmirror(float x) { return __int_as_float(__builtin_amdgcn_update_dpp(0, __float_as_int(x), 0x141, 0xF, 0xF, true)); }
DEV float dpp_mirror(float x) { return __int_as_float(__builtin_amdgcn_update_dpp(0, __float_as_int(x), 0x140, 0xF, 0xF, true)); }
DEV float shx(float v, int mask, int lane) { return __int_as_float(__builtin_amdgcn_ds_bpermute((lane ^ mask) << 2, __float_as_int(v))); }
DEV float wave_sum(float x, int lane) {
  x += dpp_xor1(x); x += dpp_xor2(x); x += dpp_hmirror(x); x += dpp_mirror(x);
  x += shx(x, 16, lane); x += shx(x, 32, lane);
  return x;
}
DEV f32x4 mfma16(bf16x8 a, bf16x8 b, f32x4 c) { return __builtin_amdgcn_mfma_f32_16x16x32_bf16(a, b, c, 0, 0, 0); }

typedef const __attribute__((address_space(4))) Params* PPtr;
DEV PPtr launder_p(PPtr q) { asm volatile("" : "+s"(q)); return q; }
DEV int tid_() { int t = threadIdx.x; asm volatile("" : "+v"(t)); return t; }
DEV int cv_of(int t) { return t < TCTX ? 0 : 1 + ((t - TCTX) >> 11); }

struct ABf16 {
  const u16* base; int ld;
  DEV bf16x8 operator()(int row, int k) const { return *(const bf16x8*)(base + (size_t)row * ld + k); }
};
struct ASig {
  const u16* base; int ld;
  DEV bf16x8 operator()(int row, int k) const {
    bf16x8 v = *(const bf16x8*)(base + (size_t)row * ld + k);
    float f[8]; unpack8(v, f);
#pragma unroll
    for (int i = 0; i < 8; ++i) f[i] = sigmoidf_(f[i]);
    return pack8(f);
  }
};
struct AModX {
  const float* xrow0; const float* sc; const float* sh;
  DEV bf16x8 operator()(int row, int k) const {
    const float* xr = xrow0 + (size_t)row * 1024 + k;
    float4 x0 = *(const float4*)xr, x1 = *(const float4*)(xr + 4);
    float4 s0 = *(const float4*)(sc + k), s1 = *(const float4*)(sc + k + 4);
    float4 h0 = *(const float4*)(sh + k), h1 = *(const float4*)(sh + k + 4);
    float f[8];
    f[0] = x0.x * (1.f + s0.x) + h0.x; f[1] = x0.y * (1.f + s0.y) + h0.y;
    f[2] = x0.z * (1.f + s0.z) + h0.z; f[3] = x0.w * (1.f + s0.w) + h0.w;
    f[4] = x1.x * (1.f + s1.x) + h1.x; f[5] = x1.y * (1.f + s1.y) + h1.y;
    f[6] = x1.z * (1.f + s1.z) + h1.z; f[7] = x1.w * (1.f + s1.w) + h1.w;
    return pack8(f);
  }
};

template <int MT, class AL>
DEV void gemm_mainloop(f32x4 (&acc)[MT][4], const AL& aload, const u16* __restrict__ Bt, int ldb, int K, u16* As, u16* Bs) {
  const int tid = tid_(), lane = tid & 63, wave = tid >> 6;
  const int wr = wave >> 1, wc = wave & 1, l15 = lane & 15, quad = lane >> 4;
  bf16x8 ra[MT], rb[4];
#pragma unroll
  for (int i = 0; i < MT; ++i) { int c = tid + i * 256; ra[i] = aload(c >> 3, (c & 7) * 8); }
#pragma unroll
  for (int i = 0; i < 4; ++i) { int c = tid + i * 256; rb[i] = *(const bf16x8*)(Bt + (size_t)(c >> 3) * ldb + (c & 7) * 8); }
  const int nk = K >> 6;
#pragma unroll 1
  for (int kt = 0; kt < nk; ++kt) {
    __syncthreads();
#pragma unroll
    for (int i = 0; i < MT; ++i) { int c = tid + i * 256; *(bf16x8*)(As + (c >> 3) * 72 + (c & 7) * 8) = ra[i]; }
#pragma unroll
    for (int i = 0; i < 4; ++i) { int c = tid + i * 256; *(bf16x8*)(Bs + (c >> 3) * 72 + (c & 7) * 8) = rb[i]; }
    __syncthreads();
    if (kt + 1 < nk) {
      const int k0 = (kt + 1) << 6;
#pragma unroll
      for (int i = 0; i < MT; ++i) { int c = tid + i * 256; ra[i] = aload(c >> 3, k0 + (c & 7) * 8); }
#pragma unroll
      for (int i = 0; i < 4; ++i) { int c = tid + i * 256; rb[i] = *(const bf16x8*)(Bt + (size_t)(c >> 3) * ldb + k0 + (c & 7) * 8); }
    }
#pragma unroll
    for (int ks = 0; ks < 2; ++ks) {
      bf16x8 a[MT], b[4];
#pragma unroll
      for (int m = 0; m < MT; ++m) a[m] = *(const bf16x8*)(As + (wr * MT * 16 + m * 16 + l15) * 72 + ks * 32 + quad * 8);
#pragma unroll
      for (int n = 0; n < 4; ++n) b[n] = *(const bf16x8*)(Bs + (wc * 64 + n * 16 + l15) * 72 + ks * 32 + quad * 8);
#pragma unroll
      for (int m = 0; m < MT; ++m)
#pragma unroll
        for (int n = 0; n < 4; ++n) acc[m][n] = mfma16(a[m], b[n], acc[m][n]);
    }
  }
}

template <int MT, bool HOIST = true>
DEV void gemm_mainloop_dma(f32x4 (&acc)[MT][4], const u16* __restrict__ A, int lda, const u16* __restrict__ Bt, int ldb, int K, unsigned char* smem,
                           bool pre = false, const u16* nA = nullptr, int nlda = 0, const u16* nBt = nullptr, int nldb = 0) {
  const int tid = tid_(), lane = tid & 63, wave = tid >> 6;
  const int wr = wave >> 1, wc = wave & 1, l15 = lane & 15, quad = lane >> 4;
  const int prow = tid >> 3, pkc = ((tid & 7) ^ ((tid >> 3) & 7)) * 8;
  const u16* ga = A + (size_t)prow * lda + pkc;
  const u16* gb = Bt + (size_t)prow * ldb + pkc;
  const int nk = K >> 6;
  const int sw = l15 & 7;
  const int slot0 = ((quad) ^ sw) * 16, slot1 = ((4 + quad) ^ sw) * 16;
  const int arow = (wr * MT * 16 + l15) * 128, brow = (wc * 64 + l15) * 128;
  if (!pre) {
    __syncthreads();
    unsigned char* sa = smem + tid * 16;
#pragma unroll
    for (int i = 0; i < MT; ++i) __builtin_amdgcn_global_load_lds((const unsigned*)(ga + (size_t)i * 32 * lda), (unsigned*)(sa + i * 4096), 16, 0, 0);
#pragma unroll
    for (int i = 0; i < 4; ++i) __builtin_amdgcn_global_load_lds((const unsigned*)(gb + (size_t)i * 32 * ldb), (unsigned*)(sa + 16384 + i * 4096), 16, 0, 0);
  }
#pragma unroll 1
  for (int kt = 0; kt < nk; ++kt) {
    asm volatile("s_waitcnt vmcnt(0)" ::: "memory");
    __syncthreads();
    if (kt + 1 < nk) {
      unsigned char* sa = smem + ((kt + 1) & 1) * 32768 + tid * 16;
      const int k0 = (kt + 1) << 6;
#pragma unroll
      for (int i = 0; i < MT; ++i) __builtin_amdgcn_global_load_lds((const unsigned*)(ga + (size_t)i * 32 * lda + k0), (unsigned*)(sa + i * 4096), 16, 0, 0);
#pragma unroll
      for (int i = 0; i < 4; ++i) __builtin_amdgcn_global_load_lds((const unsigned*)(gb + (size_t)i * 32 * ldb + k0), (unsigned*)(sa + 16384 + i * 4096), 16, 0, 0);
    } else if (nA) {
      unsigned char* sa = smem + tid * 16;
      const u16* na = nA + (size_t)prow * nlda + pkc;
      const u16* nb = nBt + (size_t)prow * nldb + pkc;
#pragma unroll
      for (int i = 0; i < MT; ++i) __builtin_amdgcn_global_load_lds((const unsigned*)(na + (size_t)i * 32 * nlda), (unsigned*)(sa + i * 4096), 16, 0, 0);
#pragma unroll
      for (int i = 0; i < 4; ++i) __builtin_amdgcn_global_load_lds((const unsigned*)(nb + (size_t)i * 32 * nldb), (unsigned*)(sa + 16384 + i * 4096), 16, 0, 0);
    }
    const unsigned char* ab = smem + (kt & 1) * 32768;
    const unsigned char* bb = ab + 16384;
    if (!HOIST) {
#pragma unroll
      for (int ks = 0; ks < 2; ++ks) {
        const int slot = ks ? slot1 : slot0;
        bf16x8 a[MT], b[4];
#pragma unroll
        for (int m = 0; m < MT; ++m) a[m] = *(const bf16x8*)(ab + arow + m * 2048 + slot);
#pragma unroll
        for (int n = 0; n < 4; ++n) b[n] = *(const bf16x8*)(bb + brow + n * 2048 + slot);
        __builtin_amdgcn_sched_barrier(0);
#pragma unroll
        for (int m = 0; m < MT; ++m)
#pragma unroll
          for (int n = 0; n < 4; ++n) acc[m][n] = mfma16(a[m], b[n], acc[m][n]);
        __builtin_amdgcn_sched_barrier(0);
      }
      continue;
    }
    bf16x8 a0[MT], b0[4], a1[MT], b1[4];
#pragma unroll
    for (int m = 0; m < MT; ++m) a0[m] = *(const bf16x8*)(ab + arow + m * 2048 + slot0);
#pragma unroll
    for (int n = 0; n < 4; ++n) b0[n] = *(const bf16x8*)(bb + brow + n * 2048 + slot0);
#pragma unroll
    for (int m = 0; m < MT; ++m) a1[m] = *(const bf16x8*)(ab + arow + m * 2048 + slot1);
#pragma unroll
    for (int n = 0; n < 4; ++n) b1[n] = *(const bf16x8*)(bb + brow + n * 2048 + slot1);
    __builtin_amdgcn_sched_barrier(0);
#pragma unroll
    for (int m = 0; m < MT; ++m)
#pragma unroll
      for (int n = 0; n < 4; ++n) acc[m][n] = mfma16(a0[m], b0[n], acc[m][n]);
#pragma unroll
    for (int m = 0; m < MT; ++m)
#pragma unroll
      for (int n = 0; n < 4; ++n) acc[m][n] = mfma16(a1[m], b1[n], acc[m][n]);
  }
}

template <int MT>
DEV void zero_acc(f32x4 (&acc)[MT][4]) {
#pragma unroll
  for (int m = 0; m < MT; ++m)
#pragma unroll
    for (int n = 0; n < 4; ++n) acc[m][n] = (f32x4){0.f, 0.f, 0.f, 0.f};
}

template <int MT, class F>
DEV void epi_foreach(f32x4 (&acc)[MT][4], F f) {
  const int tid = tid_(); const int lane = tid & 63, wave = tid >> 6;
  const int wr = wave >> 1, wc = wave & 1, l15 = lane & 15, quad = lane >> 4;
#pragma unroll
  for (int m = 0; m < MT; ++m)
#pragma unroll
    for (int n = 0; n < 4; ++n)
#pragma unroll
      for (int j = 0; j < 4; ++j) f(wr * MT * 16 + m * 16 + quad * 4 + j, wc * 64 + n * 16 + l15, acc[m][n][j]);
}

template <int MT, class F>
DEV void epi_bf16(f32x4 (&acc)[MT][4], u16* Ct, u16* dst, int ld, F f) {
  __syncthreads();
  epi_foreach<MT>(acc, [&](int r, int c, float v) { Ct[r * 136 + c] = f2bf(f(r, c, v)); });
  __syncthreads();
  const int tid = tid_();
#pragma unroll
  for (int i = 0; i < MT * 2; ++i) {
    const int c = tid + i * 256, row = c >> 4, cc = (c & 15) * 8;
    *(bf16x8*)(dst + (size_t)row * ld + cc) = *(const bf16x8*)(Ct + row * 136 + cc);
  }
}
template <class G>
DEV void epi_f32(f32x4 (&acc)[4][4], float* Cf, G g) {
  const int tid = tid_(), lane = tid & 63, wave = tid >> 6;
  const int wr = wave >> 1, wc = wave & 1, l15 = lane & 15, quad = lane >> 4;
#pragma unroll 1
  for (int half = 0; half < 2; ++half) {
    __syncthreads();
    if (wr == half) {
#pragma unroll
      for (int m = 0; m < 4; ++m)
#pragma unroll
        for (int n = 0; n < 4; ++n)
#pragma unroll
          for (int j = 0; j < 4; ++j) Cf[(m * 16 + quad * 4 + j) * 132 + wc * 64 + n * 16 + l15] = acc[m][n][j];
    }
    __syncthreads();
#pragma unroll 4
    for (int i = 0; i < 8; ++i) {
      const int c = tid + i * 256, row = c >> 5, cc = (c & 31) * 4;
      g(half * 64 + row, cc, *(const float4*)(Cf + row * 132 + cc));
    }
  }
}

#define XB_TMO 128
#define XB_XCNT(j) (256 + 64 * (j))
#define XB_XSUB(j) (1280 + 64 * (j))
#define XB_XGEN(j) (2304 + 64 * (j))
#define XB_TOP 3328
#define XB_TOPGEN 3392
#define XB_SPIN_CAP (1u << 20)
constexpr size_t OFF_XB = 499712;
DEV unsigned xb_ld(unsigned* q) { return __hip_atomic_load(q, __ATOMIC_RELAXED, __HIP_MEMORY_SCOPE_AGENT); }
DEV unsigned xb_add(unsigned* q, unsigned v) { return __hip_atomic_fetch_add(q, v, __ATOMIC_RELAXED, __HIP_MEMORY_SCOPE_AGENT); }
#define XB_SPIN(cond, bar)                                                                                         \
  do {                                                                                                             \
    unsigned _sp = 0;                                                                                              \
    while (cond) {                                                                                                 \
      __builtin_amdgcn_s_sleep(1);                                                                                 \
      if ((++_sp & 255u) == 0u) { if (xb_ld(&(bar)[XB_TMO])) break; if (_sp > XB_SPIN_CAP) { atomicAdd(&(bar)[XB_TMO], 1u); break; } } \
    }                                                                                                              \
  } while (0)
DEV void xb_complete(unsigned* bar, unsigned x, unsigned& nloc, unsigned& nx) {
  const unsigned G = gridDim.x;
  unsigned sum, cnt, mine, sp = 0u;
  for (;;) {
    sum = 0u; cnt = 0u; mine = 0u;
#pragma unroll 1
    for (unsigned j = 0; j < 16; ++j) { const unsigned c = xb_ld(&bar[XB_XCNT(j)]); sum += c; cnt += (c > 0u) ? 1u : 0u; mine = (j == x) ? c : mine; }
    if (sum == G) break;
    __builtin_amdgcn_s_sleep(1);
    if ((++sp & 255u) == 0u) { if (xb_ld(&bar[XB_TMO])) break; if (sp > XB_SPIN_CAP) { atomicAdd(&bar[XB_TMO], 1u); break; } }
  }
  nloc = mine > 0u ? mine : 1u; nx = cnt > 0u ? cnt : 1u;
}
DEV void gbar(unsigned* bar, unsigned char* smem) {
  unsigned* st = (unsigned*)(smem + SMEM_BYTES - 8);
  asm volatile("s_waitcnt vmcnt(0)" ::: "memory");
  __syncthreads();
  if (tid_() == 0) {
    __builtin_amdgcn_s_waitcnt(0);
    const unsigned x = (unsigned)__builtin_amdgcn_s_getreg((3 << 11) | 20) & 0xFu;
    unsigned nloc = st[0], nx = st[1];
    if (nloc == 0u) { xb_complete(bar, x, nloc, nx); st[0] = nloc; st[1] = nx; }
    const unsigned old = xb_add(&bar[XB_XSUB(x)], 1u);
    const unsigned gen = old / nloc;
    if (old + 1u == (gen + 1u) * nloc) {
      __builtin_amdgcn_fence(__ATOMIC_RELEASE, "agent");
      asm volatile("s_waitcnt vmcnt(0)" ::: "memory");
      const unsigned og = xb_add(&bar[XB_TOP], 1u);
      const unsigned tg = og / nx;
      if (og + 1u == (tg + 1u) * nx) xb_add(&bar[XB_TOPGEN], 1u);
      else XB_SPIN(xb_ld(&bar[XB_TOPGEN]) == tg, bar);
      __builtin_amdgcn_fence(__ATOMIC_ACQUIRE, "agent");
      xb_add(&bar[XB_XGEN(x)], 1u);
      asm volatile("s_waitcnt vmcnt(0)" ::: "memory");
    } else {
      XB_SPIN(xb_ld(&bar[XB_XGEN(x)]) == gen, bar);
      __builtin_amdgcn_fence(__ATOMIC_ACQUIRE, "agent");
      asm volatile("s_waitcnt vmcnt(0)" ::: "memory");
    }
  }
  __syncthreads();
}

DEV void transpose_tile(const float* __restrict__ src, int K, int N, u16* __restrict__ dst, int tile, float* sm) {
  const int tn = N >> 6;
  const int k0 = (tile / tn) * 64, n0 = (tile % tn) * 64;
  const int tid = tid_();
  __syncthreads();
#pragma unroll
  for (int i = 0; i < 4; ++i) {
    const int k = i * 16 + (tid >> 4), n = (tid & 15) * 4;
    const float4 v4 = *(const float4*)(src + (size_t)(k0 + k) * N + n0 + n);
    sm[k * 65 + n] = v4.x; sm[k * 65 + n + 1] = v4.y; sm[k * 65 + n + 2] = v4.z; sm[k * 65 + n + 3] = v4.w;
  }
  __syncthreads();
  const int n = tid >> 2, kc = (tid & 3) * 16;
  bf16x8 o0, o1;
#pragma unroll
  for (int i = 0; i < 8; ++i) { o0[i] = (short)f2bf(sm[(kc + i) * 65 + n]); o1[i] = (short)f2bf(sm[(kc + 8 + i) * 65 + n]); }
  u16* d = dst + (size_t)(n0 + n) * K + k0 + kc;
  *(bf16x8*)d = o0; *(bf16x8*)(d + 8) = o1;
}

DEV void mod_unit(PPtr p, int u, float* sm) {
  const int l2 = u / 96, n0 = (u % 96) * 64, tid = tid_();
  float* sc = sm; float* red = sm + 9216;
  __syncthreads();
  for (int i = tid; i < 9216; i += 256) {
    int cv = i >> 10, k = i & 1023;
    float x = cv == 0 ? p->c_ctx[k] : p->c[(cv - 1) * 1024 + k];
    sc[i] = x / (1.f + __expf(-x));
  }
  __syncthreads();
  const int kq = tid >> 6, col = tid & 63;
  float acc[9];
#pragma unroll
  for (int cv = 0; cv < 9; ++cv) acc[cv] = 0.f;
  const float* w = p->w_ada + ((size_t)l2 * 1024 + kq * 256) * 6144 + n0 + col;
#pragma unroll 4
  for (int k = 0; k < 256; ++k) {
    float wv = w[(size_t)k * 6144];
#pragma unroll
    for (int cv = 0; cv < 9; ++cv) acc[cv] += sc[cv * 1024 + kq * 256 + k] * wv;
  }
#pragma unroll
  for (int cv = 0; cv < 9; ++cv) red[(kq * 9 + cv) * 64 + col] = acc[cv];
  __syncthreads();
  float* MOD = (float*)(p->ws + OFF_MOD);
  for (int i = tid; i < 576; i += 256) {
    int cv = i >> 6, cc = i & 63;
    float s = red[(0 * 9 + cv) * 64 + cc] + red[(1 * 9 + cv) * 64 + cc] + red[(2 * 9 + cv) * 64 + cc] + red[(3 * 9 + cv) * 64 + cc];
    MOD[(size_t)(l2 * 9 + cv) * 6144 + n0 + cc] = s + p->b_ada[l2 * 6144 + n0 + cc];
  }
}

DEV void phase_convert(PPtr p, int l, unsigned char* smem) {
  float* sm = (float*)smem;
  u16* W = (u16*)(p->ws + OFF_W);
  const int tidc = tid_();
  const int total = (l == 0) ? 4448 + 1536 : 4448;
  for (int id = blockIdx.x; id < total; id += gridDim.x) {
    if (id < 1696) transpose_tile(p->w_in + (size_t)l * 1024 * 6784, 1024, 6784, W + W_IN, id, sm);
    else if (id < 2080) { int j = (id - 1696) >> 7; transpose_tile(p->w_branch + (size_t)(l * 3 + j) * 512 * 1024, 512, 1024, W + W_BR + (size_t)j * 1024 * 512, (id - 1696) & 127, sm); }
    else if (id < 2336) transpose_tile(p->w_out + (size_t)l * 1024 * 1024, 1024, 1024, W + W_OUT, id - 2080, sm);
    else if (id < 3360) transpose_tile(p->w_up + (size_t)l * 1024 * 4096, 1024, 4096, W + W_UP, id - 2336, sm);
    else if (id < 4384) transpose_tile(p->w_down + (size_t)l * 4096 * 1024, 4096, 1024, W + W_DOWN, id - 3360, sm);
    else if (id < 4400) { int d = (id - 4384) >> 3; transpose_tile(p->rwkv_w2 + (size_t)(l * 2 + d) * 64 * 512, 64, 512, W + W_W2 + (size_t)d * 512 * 64, (id - 4384) & 7, sm); }
    else if (id < 4416) { int d = (id - 4400) >> 3; transpose_tile(p->rwkv_a2 + (size_t)(l * 2 + d) * 64 * 512, 64, 512, W + W_A2 + (size_t)d * 512 * 64, (id - 4400) & 7, sm); }
    else if (id < 4432) transpose_tile(p->rwkv_g2 + (size_t)l * 128 * 512, 128, 512, W + W_G2, id - 4416, sm);
    else if (id < 4448) {
      const float* src = p->sgu_w + (size_t)l * 65536 + (id - 4432) * 4096 + tidc * 16;
      u16* dst = W + W_SGU + (id - 4432) * 4096 + tidc * 16;
      float f[16];
#pragma unroll
      for (int i = 0; i < 4; ++i) { float4 v = *(const float4*)(src + i * 4); f[i * 4] = v.x; f[i * 4 + 1] = v.y; f[i * 4 + 2] = v.z; f[i * 4 + 3] = v.w; }
      *(bf16x8*)dst = pack8(f); *(bf16x8*)(dst + 8) = pack8(f + 8);
    } else {
      const int r0 = (id - 4448) * 16;
      const float* xr0 = r0 < TCTX ? p->x_prompt + (size_t)r0 * 1024 : p->x_sample + (size_t)(r0 - TCTX) * 1024;
      const float* mod = (const float*)(p->ws + OFF_MOD) + (size_t)cv_of(r0) * 6144;
      u16* H = (u16*)(p->ws + OFF_H) + (size_t)r0 * 1024;
#pragma unroll 2
      for (int i = 0; i < 8; ++i) {
        const int c = tidc + i * 256, row = c >> 7, kc = (c & 127) * 8;
        AModX al{xr0, mod + 1024, mod};
        *(bf16x8*)(H + (size_t)row * 1024 + kc) = al(row, kc);
      }
    }
  }
}

DEV int vblock() { const int G = gridDim.x, b = blockIdx.x; return (G & 7) == 0 ? (b & 7) * (G >> 3) + (b >> 3) : b; }
DEV void tile_map(int id, int NT, int& mt, int& nt) { const int g = id / (8 * NT), r = id - g * 8 * NT; nt = r >> 3; mt = g * 8 + (r & 7); }

constexpr size_t OFF_GQ = 491520;
struct TQ { unsigned* q; int nt; int xcc; int tries; };
DEV int xcc_id() { return (int)(__builtin_amdgcn_s_getreg((3 << 11) | 20) & 7u); }
DEV int tq_pull(TQ& t, int* slot, int tid) {
  __syncthreads();
  if (tid == 0) {
    int id = -1;
    while (t.tries < 8) {
      const int x = (t.xcc + t.tries) & 7;
      const int start = (t.nt * x) >> 3, end = (t.nt * (x + 1)) >> 3;
      const int k = (int)atomicAdd(t.q + x * 16, 1u);
      if (start + k < end) { id = start + k; break; }
      ++t.tries;
    }
    *slot = id;
  }
  __syncthreads();
  return *slot;
}

DEV void inproj_qk_epilogue(PPtr p, int l, f32x4 (&acc)[4][4], u16* Ct, int m0, int nt) {
  __syncthreads();
  epi_foreach<4>(acc, [&](int r, int c, float v) { Ct[r * 136 + c] = f2bf(v); });
  __syncthreads();
  const int tid = tid_(), s = tid & 7;
  const bool isk = nt == 12;
  u16* Qf = (u16*)(p->ws + OFF_P) + F_Q;
  u16* KC = (u16*)(p->ws + OFF_KC);
  const float* g = (isk ? p->k_norm : p->q_norm) + l * 64 + s * 8;
#pragma unroll 1
  for (int it = 0; it < 8; ++it) {
    const int slot = it * 256 + tid, pair = slot >> 3, row = pair >> 1, hd = pair & 1;
    const int t = m0 + row;
    const bool lat = t >= TCTX;
    const int b = lat ? (t - TCTX) >> 11 : t >> 8;
    const int pos = lat ? (t - TCTX) & 2047 : t & 255;
    float f[8]; unpack8(*(const bf16x8*)(Ct + row * 136 + hd * 64 + s * 8), f);
    float ss = 0.f;
#pragma unroll
    for (int i = 0; i < 8; ++i) ss += f[i] * f[i];
    ss += dpp_xor1(ss); ss += dpp_xor2(ss); ss += dpp_hmirror(ss);
    const float rs = rsqrtf(ss * (1.f / 64.f) + 1e-6f);
#pragma unroll
    for (int i = 0; i < 8; ++i) f[i] = f[i] * rs * g[i];
    if (lat) {
      const float posv = (float)((s < 4) ? (pos >> 6) : (pos & 63));
#pragma unroll
      for (int i = 0; i < 8; ++i) {
        const float fi = (float)((s & 1) * 8 + i);
        const float ang = posv * exp2f(-fi * (13.287712379549449f / 16.f));
        const float cs = __cosf(ang), sn = __sinf(ang);
        const float pf = dpp_xor2(f[i]);
        f[i] = (s & 2) ? (f[i] * cs + pf * sn) : (f[i] * cs - pf * sn);
      }
    }
    const bf16x8 o = pack8(f);
    if (!isk) *(bf16x8*)(Qf + (size_t)t * 512 + (nt - 8) * 128 + hd * 64 + s * 8) = o;
    else if (lat) *(bf16x8*)(KC + KC_LAT + ((size_t)(b * 2 + hd) * 2560 + 512 + pos) * 64 + s * 8) = o;
    else {
      *(bf16x8*)(KC + ((size_t)(b * 2 + hd) * 256 + pos) * 64 + s * 8) = o;
      float* d = p->out + O_NCK + ((((size_t)b * 2 + l) * 256 + pos) * 2 + hd) * 64 + s * 8;
      *(float4*)d = make_float4(f[0], f[1], f[2], f[3]);
      *(float4*)(d + 4) = make_float4(f[4], f[5], f[6], f[7]);
    }
  }
}
DEV void inproj_v_epilogue(PPtr p, int l, f32x4 (&acc)[4][4], u16* Ct, int m0) {
  __syncthreads();
  epi_foreach<4>(acc, [&](int r, int c, float v) { Ct[r * 136 + c] = f2bf(v); });
  __syncthreads();
  const int tid = tid_();
  u16* VT = (u16*)(p->ws + OFF_VT);
  const bool lat = m0 >= TCTX;
  const int b = lat ? (m0 - TCTX) >> 11 : m0 >> 8;
  const int pos0 = lat ? (m0 - TCTX) & 2047 : m0 & 255;
  if (!lat) {
#pragma unroll 2
    for (int i = 0; i < 8; ++i) {
      const int c = tid + i * 256, row = c >> 4, cc = (c & 15) * 8;
      float f[8]; unpack8(*(const bf16x8*)(Ct + row * 136 + cc), f);
      float* d = p->out + O_NCV + ((((size_t)b * 2 + l) * 256 + pos0 + row) * 2 + (cc >> 6)) * 64 + (cc & 63);
      *(float4*)d = make_float4(f[0], f[1], f[2], f[3]);
      *(float4*)(d + 4) = make_float4(f[4], f[5], f[6], f[7]);
    }
  }
#pragma unroll 2
  for (int i = 0; i < 8; ++i) {
    const int c = tid + i * 256, kvh = c >> 10, d = (c >> 4) & 63, kc = c & 15;
    bf16x8 o;
#pragma unroll
    for (int e = 0; e < 8; ++e) o[e] = (short)Ct[(kc * 8 + e) * 136 + kvh * 64 + d];
    u16* dst = lat ? VT + KC_LAT + ((size_t)(b * 2 + kvh) * 64 + d) * 2560 + 512 + pos0 + kc * 8
                   : VT + ((size_t)(b * 2 + kvh) * 64 + d) * 256 + pos0 + kc * 8;
    *(bf16x8*)dst = o;
  }
}
DEV void cache_tile(PPtr p, int l, int u, unsigned char* smem) {
  u16* KC = (u16*)(p->ws + OFF_KC);
  u16* VT = (u16*)(p->ws + OFF_VT);
  const int tid = tid_();
  const int b = u >> 4, kvh = (u >> 3) & 1, kb = u & 7;
  u16* tile = (u16*)smem;
  const int key = tid >> 2, dc = (tid & 3) * 16;
  float f[16], fk[16];
  __syncthreads();
  const int pk = kb * 64 + key;
  const float* sv = p->cache_v + (((size_t)(b * 2 + l) * 512 + pk) * 2 + kvh) * 64 + dc;
  const float* sk = p->cache_k + (((size_t)(b * 2 + l) * 512 + pk) * 2 + kvh) * 64 + dc;
#pragma unroll
  for (int i = 0; i < 4; ++i) {
    float4 v = *(const float4*)(sv + i * 4); f[i * 4] = v.x; f[i * 4 + 1] = v.y; f[i * 4 + 2] = v.z; f[i * 4 + 3] = v.w;
    float4 k = *(const float4*)(sk + i * 4); fk[i * 4] = k.x; fk[i * 4 + 1] = k.y; fk[i * 4 + 2] = k.z; fk[i * 4 + 3] = k.w;
  }
  u16* kd = KC + KC_LAT + ((size_t)(b * 2 + kvh) * 2560 + pk) * 64 + dc;
  *(bf16x8*)kd = pack8(fk); *(bf16x8*)(kd + 8) = pack8(fk + 8);
#pragma unroll
  for (int i = 0; i < 16; ++i) tile[(dc + i) * 72 + key] = f2bf(f[i]);
  __syncthreads();
  const int d = tid >> 2, kc = (tid & 3) * 16;
  bf16x8 o0 = *(const bf16x8*)(tile + d * 72 + kc), o1 = *(const bf16x8*)(tile + d * 72 + kc + 8);
  u16* dst = VT + KC_LAT + ((size_t)(b * 2 + kvh) * 64 + d) * 2560 + kb * 64 + kc;
  *(bf16x8*)dst = o0; *(bf16x8*)(dst + 8) = o1;
}

DEV void phase_inproj(PPtr p, int l, unsigned char* smem) {
  u16* Ct = (u16*)(smem + 32768);
  const u16* W = (const u16*)(p->ws + OFF_W);
  const u16* H = (const u16*)(p->ws + OFF_H);
  u16* P = (u16*)(p->ws + OFF_P);
  TQ tq{(unsigned*)(p->ws + OFF_GQ) + (l * 5 + 0) * 128, 192 * 29, xcc_id(), 0};
  int* slot = (int*)(smem + SMEM_BYTES - 16);
  const int tidq = tid_();
  bool pre = false;
  int id = tq_pull(tq, slot, tidq);
  while (id >= 0) {
    int mt, nt; tile_map(id, 29, mt, nt);
    const int m0 = mt * 128, n0 = nt * 128;
    const int idn = tq_pull(tq, slot, tidq); const bool hn = idn >= 0;
    int mtn = 0, ntn = 0; if (hn) tile_map(idn, 29, mtn, ntn);
    f32x4 acc[4][4]; zero_acc<4>(acc);
    gemm_mainloop_dma<4>(acc, H + (size_t)m0 * 1024, 1024, W + W_IN + (size_t)n0 * 1024, 1024, 1024, smem, pre,
                         hn ? H + (size_t)mtn * 128 * 1024 : nullptr, 1024, W + W_IN + (size_t)ntn * 128 * 1024, 1024);
    pre = hn;
    if (nt >= 8 && nt <= 12) { inproj_qk_epilogue(p, l, acc, Ct, m0, nt); id = idn; continue; }
    if (nt == 13) { inproj_v_epilogue(p, l, acc, Ct, m0); id = idn; continue; }
    u16* dst; int ld;
    if (n0 < 512) { dst = P + F_UA + n0; ld = 512; }
    else if (n0 < 1024) { dst = P + F_VA + (n0 - 512); ld = 512; }
    else if (n0 < 1536) { dst = P + F_Q + (n0 - 1024); ld = 512; }
    else if (n0 < 1664) { dst = P + F_KK; ld = 128; }
    else if (n0 < 1792) { dst = P + F_VV; ld = 128; }
    else if (n0 < 3328) { dst = P + F_RKV + (n0 - 1792); ld = 1536; }
    else if (n0 < 3584) { dst = P + F_LORA + (n0 - 3328); ld = 256; }
    else { dst = P + F_GD; ld = 128; }
    dst += (size_t)m0 * ld;
    epi_bf16<4>(acc, Ct, dst, ld, [](int, int, float v) { return v; });
    id = idn;
  }
  for (int u = blockIdx.x; u < 128; u += gridDim.x) cache_tile(p, l, u, smem);
}


DEV void attn_item(PPtr p, int item, bool lat, unsigned char* smem) {
  u16* Ks = (u16*)smem; u16* Vs = Ks + 64 * 72;
  u16* P = (u16*)(p->ws + OFF_P);
  const int tid = tid_(), lane = tid & 63, wave = tid >> 6, l15 = lane & 15, quad = lane >> 4;
  int b, kvh, qb, LK; size_t tq0; const u16 *Kc, *VTc;
  if (lat) {
    b = item >> 7; kvh = (item >> 6) & 1; qb = item & 63; LK = 2560;
    tq0 = TCTX + (size_t)b * 2048 + qb * 32;
    Kc = (const u16*)(p->ws + OFF_KC) + KC_LAT + (size_t)(b * 2 + kvh) * 2560 * 64;
    VTc = (const u16*)(p->ws + OFF_VT) + KC_LAT + (size_t)(b * 2 + kvh) * 64 * 2560;
  } else {
    b = item >> 4; kvh = (item >> 3) & 1; qb = item & 7; LK = 256;
    tq0 = (size_t)b * 256 + qb * 32;
    Kc = (const u16*)(p->ws + OFF_KC) + (size_t)(b * 2 + kvh) * 256 * 64;
    VTc = (const u16*)(p->ws + OFF_VT) + (size_t)(b * 2 + kvh) * 64 * 256;
  }
  const int hq = kvh * 4 + wave;
  bf16x8 qf[2][2];
#pragma unroll
  for (int qt = 0; qt < 2; ++qt)
#pragma unroll
    for (int ks = 0; ks < 2; ++ks) qf[qt][ks] = *(const bf16x8*)(P + F_Q + (tq0 + qt * 16 + l15) * 512 + hq * 64 + ks * 32 + quad * 8);
  f32x4 o[4][2];
#pragma unroll
  for (int dt = 0; dt < 4; ++dt)
#pragma unroll
    for (int qt = 0; qt < 2; ++qt) o[dt][qt] = (f32x4){0.f, 0.f, 0.f, 0.f};
  float mrow[2] = {-1e30f, -1e30f}, lrow[2] = {0.f, 0.f};
  const float C = 0.125f * 1.4426950408889634f;
  bf16x8 rk[2], rv[2];
#pragma unroll
  for (int i = 0; i < 2; ++i) {
    int c = tid + i * 256, r = c >> 3, cc = (c & 7) * 8;
    rk[i] = *(const bf16x8*)(Kc + (size_t)r * 64 + cc);
    rv[i] = *(const bf16x8*)(VTc + (size_t)r * LK + cc);
  }
  const int nt = LK >> 6;
  for (int kt = 0; kt < nt; ++kt) {
    __syncthreads();
#pragma unroll
    for (int i = 0; i < 2; ++i) {
      int c = tid + i * 256, r = c >> 3, cc = (c & 7) * 8;
      *(bf16x8*)(Ks + r * 72 + cc) = rk[i];
      *(bf16x8*)(Vs + r * 72 + cc) = rv[i];
    }
    __syncthreads();
    if (kt + 1 < nt) {
      const int key0 = (kt + 1) * 64;
#pragma unroll
      for (int i = 0; i < 2; ++i) {
        int c = tid + i * 256, r = c >> 3, cc = (c & 7) * 8;
        rk[i] = *(const bf16x8*)(Kc + (size_t)(key0 + r) * 64 + cc);
        rv[i] = *(const bf16x8*)(VTc + (size_t)r * LK + key0 + cc);
      }
    }
    f32x4 s[4][2];
#pragma unroll
    for (int nk = 0; nk < 4; ++nk)
#pragma unroll
      for (int qt = 0; qt < 2; ++qt) s[nk][qt] = (f32x4){0.f, 0.f, 0.f, 0.f};
#pragma unroll
    for (int ks = 0; ks < 2; ++ks)
#pragma unroll
      for (int nk = 0; nk < 4; ++nk) {
        bf16x8 a = *(const bf16x8*)(Ks + (nk * 16 + l15) * 72 + ks * 32 + quad * 8);
#pragma unroll
        for (int qt = 0; qt < 2; ++qt) s[nk][qt] = mfma16(a, qf[qt][ks], s[nk][qt]);
      }
#pragma unroll
    for (int qt = 0; qt < 2; ++qt) {
      float mx = -1e30f;
#pragma unroll
      for (int nk = 0; nk < 4; ++nk)
#pragma unroll
        for (int j = 0; j < 4; ++j) mx = fmaxf(mx, s[nk][qt][j]);
      mx = fmaxf(mx, shx(mx, 16, lane)); mx = fmaxf(mx, shx(mx, 32, lane));
      const float mnew = fmaxf(mrow[qt], mx);
      const float alpha = __builtin_amdgcn_exp2f((mrow[qt] - mnew) * C);
      mrow[qt] = mnew;
      lrow[qt] *= alpha;
#pragma unroll
      for (int dt = 0; dt < 4; ++dt) { o[dt][qt][0] *= alpha; o[dt][qt][1] *= alpha; o[dt][qt][2] *= alpha; o[dt][qt][3] *= alpha; }
      const float nmc = -mrow[qt] * C;
      float ls = 0.f;
#pragma unroll
      for (int nk = 0; nk < 4; ++nk)
#pragma unroll
        for (int j = 0; j < 4; ++j) { float pv = __builtin_amdgcn_exp2f(__builtin_fmaf(s[nk][qt][j], C, nmc)); ls += pv; s[nk][qt][j] = pv; }
      lrow[qt] += ls;
    }
#pragma unroll
    for (int ks = 0; ks < 2; ++ks) {
      bf16x8 pf[2];
#pragma unroll
      for (int qt = 0; qt < 2; ++qt) {
#pragma unroll
        for (int j = 0; j < 4; ++j) { pf[qt][j] = (short)f2bf(s[2 * ks][qt][j]); pf[qt][4 + j] = (short)f2bf(s[2 * ks + 1][qt][j]); }
      }
#pragma unroll
      for (int dt = 0; dt < 4; ++dt) {
        const u16* vr = Vs + (dt * 16 + l15) * 72 + quad * 4;
        bf16x4 v0 = *(const bf16x4*)(vr + (2 * ks) * 16), v1 = *(const bf16x4*)(vr + (2 * ks + 1) * 16);
        bf16x8 a;
        a[0] = v0[0]; a[1] = v0[1]; a[2] = v0[2]; a[3] = v0[3]; a[4] = v1[0]; a[5] = v1[1]; a[6] = v1[2]; a[7] = v1[3];
#pragma unroll
        for (int qt = 0; qt < 2; ++qt) o[dt][qt] = mfma16(a, pf[qt], o[dt][qt]);
      }
    }
  }
#pragma unroll
  for (int qt = 0; qt < 2; ++qt) {
    float lsum = lrow[qt];
    lsum += shx(lsum, 16, lane); lsum += shx(lsum, 32, lane);
    const float inv = frcp(lsum);
#pragma unroll
    for (int dt = 0; dt < 4; ++dt) {
      bf16x4 ov;
#pragma unroll
      for (int j = 0; j < 4; ++j) ov[j] = (short)f2bf(o[dt][qt][j] * inv);
      *(bf16x4*)(P + F_Q + (tq0 + qt * 16 + l15) * 512 + hq * 64 + dt * 16 + quad * 4) = ov;
    }
  }
}

DEV void sgu_item(PPtr p, int l, int item, unsigned char* smem) {
  u16* VnT = (u16*)smem;
  float* stats = (float*)(smem + 128 * 136 * 2);
  u16* P = (u16*)(p->ws + OFF_P);
  const u16* Wsb = (const u16*)(p->ws + OFF_W) + W_SGU;
  const int tid = tid_(), lane = tid & 63, wave = tid >> 6, l15 = lane & 15, quad = lane >> 4;
  const int wr = wave >> 1, wc = wave & 1;
  const size_t t0 = (size_t)item * 128;
  __syncthreads();
  {
    const int tok = tid >> 1, half = tid & 1;
    const u16* vr = P + F_VA + (t0 + tok) * 512 + half * 256;
    float sum = 0.f, sq = 0.f;
    for (int i = 0; i < 32; ++i) {
      float f[8]; unpack8(*(const bf16x8*)(vr + i * 8), f);
#pragma unroll
      for (int e = 0; e < 8; ++e) { sum += f[e]; sq += f[e] * f[e]; }
    }
    sum += dpp_xor1(sum); sq += dpp_xor1(sq);
    const float mu = sum * (1.f / 512.f);
    const float var = fmaxf(sq * (1.f / 512.f) - mu * mu, 0.f);
    if (half == 0) { stats[tok * 2] = mu; stats[tok * 2 + 1] = rsqrtf(var + 1e-5f); }
  }
  __syncthreads();
  for (int g = 0; g < 4; ++g) {
    {
      const int q = tid & 127, hf = tid >> 7;
      const float mu = stats[q * 2], rs = stats[q * 2 + 1];
      const u16* vr = P + F_VA + (t0 + q) * 512 + g * 128 + hf * 64;
      const float* lg = p->sgu_ln_g + l * 512 + g * 128 + hf * 64;
      const float* lb = p->sgu_ln_b + l * 512 + g * 128 + hf * 64;
      for (int i = 0; i < 8; ++i) {
        float f[8]; unpack8(*(const bf16x8*)(vr + i * 8), f);
#pragma unroll
        for (int e = 0; e < 8; ++e) VnT[(hf * 64 + i * 8 + e) * 136 + q] = f2bf((f[e] - mu) * rs * lg[i * 8 + e] + lb[i * 8 + e]);
      }
    }
    __syncthreads();
    f32x4 acc[4][4]; zero_acc<4>(acc);
#pragma unroll
    for (int ks = 0; ks < 4; ++ks) {
      bf16x8 a[4], bb[4];
#pragma unroll
      for (int m = 0; m < 4; ++m) a[m] = *(const bf16x8*)(Wsb + (size_t)g * 16384 + (wr * 64 + m * 16 + l15) * 128 + ks * 32 + quad * 8);
#pragma unroll
      for (int n = 0; n < 4; ++n) bb[n] = *(const bf16x8*)(VnT + (wc * 64 + n * 16 + l15) * 136 + ks * 32 + quad * 8);
#pragma unroll
      for (int m = 0; m < 4; ++m)
#pragma unroll
        for (int n = 0; n < 4; ++n) acc[m][n] = mfma16(a[m], bb[n], acc[m][n]);
    }
    const float* bias = p->sgu_b + l * 512 + g * 128;
    u16* ua = P + F_UA + t0 * 512 + g * 128;
    {
      u16* Cs = (u16*)(smem + 128 * 136 * 2 + 1024);
      epi_foreach<4>(acc, [&](int r, int c, float v) { Cs[r * 136 + c] = f2bf(v + bias[r]); });
      __syncthreads();
#pragma unroll 2
      for (int i = 0; i < 8; ++i) {
        const int c = tid + i * 256, row = c >> 4, cc = (c & 15) * 8;
        u16* e = ua + (size_t)row * 512 + cc;
        float fu[8], fs[8];
        unpack8(*(const bf16x8*)e, fu); unpack8(*(const bf16x8*)(Cs + row * 136 + cc), fs);
#pragma unroll
        for (int k = 0; k < 8; ++k) fu[k] *= fs[k];
        *(bf16x8*)e = pack8(fu);
      }
    }
    __syncthreads();
  }
}

template <int RS>
DEV void scan_item(PPtr p, int l, int item, bool lat, unsigned char* smem) {
  float* sR = (float*)smem;
  float* sK = sR + 2048; float* sV = sK + 2048; float* sW = sV + 2048; float* sA = sW + 2048; float* sB = sA + 2048;
  float* sY = sB + 2048;
  u16* XW = (u16*)(sY + 2048);
  u16* XA = XW + 32 * 72;
  const u16* P = (const u16*)(p->ws + OFF_P);
  const u16* Wb = (const u16*)(p->ws + OFF_W);
  u16* Y = (u16*)(p->ws + OFF_Y);
  float* COEF = (float*)(p->ws + OFF_COEF);
  const int tid = tid_(), lane = tid & 63, wave = tid >> 6, l15 = lane & 15, quad = lane >> 4;
  constexpr int LPR = 4 * RS, KPL = 16 / RS, ROWS = 64 / RS, NV4 = KPL / 4, KP2 = KPL / 2;
  if (lat) __builtin_amdgcn_s_setprio(3);
  const int rpart = item % RS, sci = item / RS;
  const int b = sci >> 4, h = (sci >> 1) & 7, d = sci & 1;
  const int L = lat ? 2048 : 256;
  const size_t tbase = lat ? TCTX + (size_t)b * 2048 : (size_t)b * 256;
  const int v = rpart * ROWS + tid / LPR, kq = tid % LPR, key0 = kq * KPL;
  f32x2 S2[KP2];
  if (lat) {
    const float* s0 = p->state_wkv + ((((size_t)(b * 2 + l) * 2 + d) * 8 + h) * 64 + v) * 64 + key0;
#pragma unroll
    for (int i = 0; i < NV4; ++i) { float4 t4 = *(const float4*)(s0 + i * 4); S2[2 * i] = (f32x2){t4.x, t4.y}; S2[2 * i + 1] = (f32x2){t4.z, t4.w}; }
  } else {
#pragma unroll
    for (int i = 0; i < KP2; ++i) S2[i] = (f32x2){0.f, 0.f};
  }
  const float* mu = p->rwkv_mu + (size_t)(l * 2 + d) * 1664;
  const int sl = tid >> 3, part = tid & 7, ch0 = part * 8;
  float* sC = (float*)(XA + 32 * 72);
  __syncthreads();
  if (tid < 64) {
    sC[tid] = mu[h * 64 + tid]; sC[64 + tid] = mu[512 + h * 64 + tid]; sC[128 + tid] = mu[1024 + h * 64 + tid];
    sC[192 + tid] = mu[1536 + tid]; sC[256 + tid] = mu[1600 + tid];
    sC[320 + tid] = p->rwkv_k_k[l * 512 + h * 64 + tid]; sC[384 + tid] = p->rwkv_k_a[l * 512 + h * 64 + tid]; sC[448 + tid] = p->rwkv_r_k[l * 512 + h * 64 + tid];
  }
  __syncthreads();
  const int lm = wave & 1, ln0 = (wave >> 1) * 2;
  const u16* w2T = Wb + W_W2 + (size_t)d * 512 * 64 + (size_t)(h * 64) * 64;
  const u16* a2T = Wb + W_A2 + (size_t)d * 512 * 64 + (size_t)(h * 64) * 64;
  const float* w0 = p->rwkv_w0 + (size_t)(l * 2 + d) * 512 + h * 64;
  const float* a0 = p->rwkv_a0 + (size_t)(l * 2 + d) * 512 + h * 64;
  const int nch = L >> 5;
  bf16x8 q_r, q_k, q_v, q_w, q_a, n_r, n_k, n_v, n_w, n_a;
#define SCAN_FETCH(cc)                                                                                   \
  {                                                                                                      \
    const int s_ = (cc) * 32 + sl;                                                                       \
    const size_t t_ = tbase + (d ? (L - 1 - s_) : s_);                                                   \
    const size_t tn_ = (s_ > 0) ? (d ? t_ + 1 : t_ - 1) : t_;                                            \
    q_r = *(const bf16x8*)(P + F_RKV + t_ * 1536 + h * 64 + ch0);                                        \
    q_k = *(const bf16x8*)(P + F_RKV + t_ * 1536 + 512 + h * 64 + ch0);                                  \
    q_v = *(const bf16x8*)(P + F_RKV + t_ * 1536 + 1024 + h * 64 + ch0);                                 \
    q_w = *(const bf16x8*)(P + F_LORA + t_ * 256 + d * 128 + ch0);                                       \
    q_a = *(const bf16x8*)(P + F_LORA + t_ * 256 + d * 128 + 64 + ch0);                                  \
    n_r = *(const bf16x8*)(P + F_RKV + tn_ * 1536 + h * 64 + ch0);                                       \
    n_k = *(const bf16x8*)(P + F_RKV + tn_ * 1536 + 512 + h * 64 + ch0);                                 \
    n_v = *(const bf16x8*)(P + F_RKV + tn_ * 1536 + 1024 + h * 64 + ch0);                                \
    n_w = *(const bf16x8*)(P + F_LORA + tn_ * 256 + d * 128 + ch0);                                      \
    n_a = *(const bf16x8*)(P + F_LORA + tn_ * 256 + d * 128 + 64 + ch0);                                 \
  }
  SCAN_FETCH(0)
  bf16x8 bwf[2][2], baf[2][2];
#pragma unroll
  for (int ks = 0; ks < 2; ++ks)
#pragma unroll
    for (int n = 0; n < 2; ++n) {
      bwf[ks][n] = *(const bf16x8*)(w2T + (size_t)((ln0 + n) * 16 + l15) * 64 + ks * 32 + quad * 8);
      baf[ks][n] = *(const bf16x8*)(a2T + (size_t)((ln0 + n) * 16 + l15) * 64 + ks * 32 + quad * 8);
    }
  for (int c = 0; c < nch; ++c) {
    const int s = c * 32 + sl;
    const int pos = d ? (L - 1 - s) : s;
    const size_t t = tbase + pos;
    const bool hasnb = s > 0;
    float fr[8], fk[8], fv[8], fw[8], fa[8];
    {
      unpack8(q_r, fr); unpack8(q_k, fk); unpack8(q_v, fv); unpack8(q_w, fw); unpack8(q_a, fa);
      float nr[8], nk[8], nv[8], nw[8], na[8];
      unpack8(n_r, nr); unpack8(n_k, nk); unpack8(n_v, nv); unpack8(n_w, nw); unpack8(n_a, na);
      if (!hasnb) {
#pragma unroll
        for (int i = 0; i < 8; ++i) { nr[i] = 0.f; nk[i] = 0.f; nv[i] = 0.f; nw[i] = 0.f; na[i] = 0.f; }
      }
#pragma unroll
      for (int i = 0; i < 8; ++i) {
        fr[i] += sC[ch0 + i] * (nr[i] - fr[i]); fk[i] += sC[64 + ch0 + i] * (nk[i] - fk[i]); fv[i] += sC[128 + ch0 + i] * (nv[i] - fv[i]);
        fw[i] += sC[192 + ch0 + i] * (nw[i] - fw[i]); fa[i] += sC[256 + ch0 + i] * (na[i] - fa[i]);
      }
    }
    if (c + 1 < nch) SCAN_FETCH(c + 1)
    {
      float tw[8];
#pragma unroll
      for (int i = 0; i < 8; ++i) tw[i] = 1.f - 2.f * frcp(__expf(2.f * fw[i]) + 1.f);
      *(bf16x8*)(XW + sl * 72 + ch0) = pack8(tw);
      *(bf16x8*)(XA + sl * 72 + ch0) = pack8(fa);
#pragma unroll
      for (int i = 0; i < 8; ++i) { sR[sl * 64 + ch0 + i] = fr[i]; sV[sl * 64 + ch0 + i] = fv[i]; }
    }
    __syncthreads();
    {
      f32x4 aw[2], aa[2];
#pragma unroll
      for (int n = 0; n < 2; ++n) { aw[n] = (f32x4){0.f, 0.f, 0.f, 0.f}; aa[n] = (f32x4){0.f, 0.f, 0.f, 0.f}; }
#pragma unroll
      for (int ks = 0; ks < 2; ++ks) {
        bf16x8 xw = *(const bf16x8*)(XW + (lm * 16 + l15) * 72 + ks * 32 + quad * 8);
        bf16x8 xa = *(const bf16x8*)(XA + (lm * 16 + l15) * 72 + ks * 32 + quad * 8);
#pragma unroll
        for (int n = 0; n < 2; ++n) {
          aw[n] = mfma16(xw, bwf[ks][n], aw[n]);
          aa[n] = mfma16(xa, baf[ks][n], aa[n]);
        }
      }
#pragma unroll
      for (int n = 0; n < 2; ++n) {
        const int ch = (ln0 + n) * 16 + l15;
        const float w0c = w0[ch], a0c = a0[ch];
#pragma unroll
        for (int j = 0; j < 4; ++j) {
          const int row = lm * 16 + quad * 4 + j;
          const float z = w0c + aw[n][j];
          sW[row * 64 + ch] = __expf(-0.60653065971263342f * sigmoidf_(z));
          sA[row * 64 + ch] = sigmoidf_(a0c + aa[n][j]);
        }
      }
    }
    __syncthreads();
    {
      float av[8], kk[8], ssq = 0.f, cf = 0.f;
#pragma unroll
      for (int i = 0; i < 8; ++i) { av[i] = sA[sl * 64 + ch0 + i]; kk[i] = fk[i] * sC[320 + ch0 + i]; ssq += kk[i] * kk[i]; }
      ssq += dpp_xor1(ssq); ssq += dpp_xor2(ssq); ssq += dpp_hmirror(ssq);
      const float inv = rsqrtf(fmaxf(ssq, 1e-24f));
#pragma unroll
      for (int i = 0; i < 8; ++i) {
        const float kn = kk[i] * inv;
        const float km = fk[i] * (1.f + (av[i] - 1.f) * sC[384 + ch0 + i]);
        cf += fr[i] * km * sC[448 + ch0 + i];
        sK[sl * 64 + ch0 + i] = km;
        sA[sl * 64 + ch0 + i] = -kn;
        sB[sl * 64 + ch0 + i] = kn * av[i];
      }
      cf += dpp_xor1(cf); cf += dpp_xor2(cf); cf += dpp_hmirror(cf);
      if (part == 0 && rpart == 0) COEF[(t * 8 + h) * 2 + d] = cf;
    }
    __syncthreads();
    {
      f32x2 wA[KP2], kA[KP2], aA[KP2], bA[KP2], rA[KP2]; float vA;
#define SCAN_LD(X_, arr_, st_)                                                                                   \
  _Pragma("unroll") for (int i = 0; i < NV4; ++i) {                                                              \
    const float4 t4 = *(const float4*)((arr_) + (st_) * 64 + key0 + i * 4);                                      \
    X_[2 * i] = (f32x2){t4.x, t4.y}; X_[2 * i + 1] = (f32x2){t4.z, t4.w};                                        \
  }
      SCAN_LD(aA, sA, 0) SCAN_LD(kA, sK, 0) SCAN_LD(bA, sB, 0) SCAN_LD(wA, sW, 0) SCAN_LD(rA, sR, 0)
      vA = sV[v];
#pragma unroll 2
      for (int st = 0; st < 32; ++st) {
        const int sn = (st + 1) & 31;
        f32x2 sacc = S2[0] * aA[0];
#pragma unroll
        for (int i = 1; i < KP2; ++i) sacc = __builtin_elementwise_fma(S2[i], aA[i], sacc);
        SCAN_LD(aA, sA, sn)
        const f32x2 vv = {vA, vA};
        f32x2 vk[KP2];
#pragma unroll
        for (int i = 0; i < KP2; ++i) vk[i] = vv * kA[i];
        SCAN_LD(kA, sK, sn)
        vA = sV[sn * 64 + v];
        float sa = sacc.x + sacc.y;
        sa += dpp_xor1(sa); sa += dpp_xor2(sa);
        if (LPR >= 8) sa += dpp_hmirror(sa);
        if (LPR >= 16) sa += dpp_mirror(sa);
        const f32x2 sav = {sa, sa};
#pragma unroll
        for (int i = 0; i < KP2; ++i) vk[i] = __builtin_elementwise_fma(sav, bA[i], vk[i]);
        SCAN_LD(bA, sB, sn)
#pragma unroll
        for (int i = 0; i < KP2; ++i) S2[i] = __builtin_elementwise_fma(S2[i], wA[i], vk[i]);
        SCAN_LD(wA, sW, sn)
        f32x2 yacc = S2[0] * rA[0];
#pragma unroll
        for (int i = 1; i < KP2; ++i) yacc = __builtin_elementwise_fma(S2[i], rA[i], yacc);
        SCAN_LD(rA, sR, sn)
        float y = yacc.x + yacc.y;
        y += dpp_xor1(y); y += dpp_xor2(y);
        if (LPR >= 8) y += dpp_hmirror(y);
        if (LPR >= 16) y += dpp_mirror(y);
        sY[st * 64 + v] = y;
      }
#undef SCAN_LD
    }
    __syncthreads();
    {
      float yv[8];
#pragma unroll
      for (int i = 0; i < 8; ++i) yv[i] = sY[sl * 64 + ch0 + i];
      if (ch0 >= rpart * ROWS && ch0 < (rpart + 1) * ROWS) *(bf16x8*)(Y + (size_t)d * TT * 512 + t * 512 + h * 64 + ch0) = pack8(yv);
    }
#undef SCAN_FETCH_DUMMY
  }
  __builtin_amdgcn_s_setprio(0);
  if (!lat) {
    float* dst = p->out + O_NST + ((((size_t)(b * 2 + l) * 2 + d) * 8 + h) * 64 + v) * 64 + key0;
#pragma unroll
    for (int i = 0; i < NV4; ++i) *(float4*)(dst + i * 4) = make_float4(S2[2 * i].x, S2[2 * i].y, S2[2 * i + 1].x, S2[2 * i + 1].y);
  }
  __syncthreads();
}

constexpr int SCAN_RS = 2;
constexpr int SCAN_RS_CTX = 1;
constexpr int MIX_LS = 128 * SCAN_RS, MIX_CS = 512 * SCAN_RS_CTX, MIX_LA = 1024, MIX_SG = 192, MIX_CA = 512;
constexpr int MIX_B = MIX_LA + MIX_CS + MIX_SG + MIX_CA;
constexpr size_t OFF_CUTAB = 458752;

DEV void phase_mix(PPtr p, int l, unsigned char* smem) {
  unsigned* ctrA = (unsigned*)(p->ws + OFF_CTR) + l * 2;
  unsigned* ctrB = ctrA + 1;
  int* slot = (int*)(smem + SMEM_BYTES - 16);
  const int tidm = tid_();
  __syncthreads();
  if (tidm == 0) {
    const unsigned hw = __builtin_amdgcn_s_getreg((31 << 11) | 4), xcc = __builtin_amdgcn_s_getreg((3 << 11) | 20);
    const unsigned key = ((xcc & 15u) << 8) | ((hw >> 8) & 255u);
    slot[1] = (int)atomicAdd((unsigned*)(p->ws + OFF_CUTAB) + l * 4096 + key, 1u);
  }
  __syncthreads();
  const bool primary = slot[1] == 0;
  bool a_open = true, b_open = true;
  for (;;) {
    __syncthreads();
    if (tidm == 0) {
      int it = -1;
      if (primary) {
        if (a_open) { it = (int)atomicAdd(ctrA, 1u); if (it >= MIX_LS) { a_open = false; it = -1; } }
        if (it < 0 && b_open) { it = (int)atomicAdd(ctrB, 1u); if (it >= MIX_B) { b_open = false; it = -1; } else it += MIX_LS; }
      } else {
        if (b_open) { it = (int)atomicAdd(ctrB, 1u); if (it >= MIX_B) { b_open = false; it = -1; } else it += MIX_LS; }
        if (it < 0 && a_open) { it = (int)atomicAdd(ctrA, 1u); if (it >= MIX_LS) { a_open = false; it = -1; } }
      }
      *slot = it;
    }
    __syncthreads();
    int item = *slot;
    if (item < 0) break;
    if (item < MIX_LS) scan_item<SCAN_RS>(p, l, item, true, smem);
    else if ((item -= MIX_LS) < MIX_LA) attn_item(p, item, true, smem);
    else if ((item -= MIX_LA) < MIX_CS) scan_item<SCAN_RS_CTX>(p, l, item, false, smem);
    else if ((item -= MIX_CS) < MIX_SG) sgu_item(p, l, item, smem);
    else attn_item(p, item - MIX_SG, false, smem);
  }
}

DEV void phase_fin(PPtr p, int l, unsigned char* smem) {
  u16* As = (u16*)smem; u16* Bs = As + 128 * 72; u16* Zs = Bs + 128 * 72;
  const u16* P = (const u16*)(p->ws + OFF_P);
  const u16* W = (const u16*)(p->ws + OFF_W);
  u16* Y = (u16*)(p->ws + OFF_Y);
  const float* COEF = (const float*)(p->ws + OFF_COEF);
  const int tid = tid_();
  for (int id = vblock(); id < 384 * 4; id += gridDim.x) {
    int mt, nt; tile_map(id, 4, mt, nt);
    const int m0 = mt * 64, c0 = nt * 128;
    __syncthreads();
    for (int it = 0; it < 4; ++it) {
      const int slot = it * 256 + tid, pair = slot >> 3, sub = slot & 7;
      const int tok = pair >> 1, hd = pair & 1;
      const int ch = c0 + hd * 64 + sub * 8, head = nt * 2 + hd;
      const size_t t = (size_t)m0 + tok;
      const bool lat = t >= TCTX;
      const int pos = lat ? (int)((t - TCTX) & 2047) : (int)(t & 255);
      const int L = lat ? 2048 : 256;
      float y0[8], y1[8];
      unpack8(*(const bf16x8*)(Y + t * 512 + ch), y0);
      unpack8(*(const bf16x8*)(Y + (size_t)TT * 512 + t * 512 + ch), y1);
      float sum = 0.f;
#pragma unroll
      for (int i = 0; i < 8; ++i) { y0[i] += y1[i]; sum += y0[i]; }
      sum += dpp_xor1(sum); sum += dpp_xor2(sum); sum += dpp_hmirror(sum);
      const float mu = sum * (1.f / 64.f);
      float sq = 0.f;
#pragma unroll
      for (int i = 0; i < 8; ++i) { y0[i] -= mu; sq += y0[i] * y0[i]; }
      sq += dpp_xor1(sq); sq += dpp_xor2(sq); sq += dpp_hmirror(sq);
      const float rs = rsqrtf(sq * (1.f / 64.f) + GN_EPS);
      float vv[8], n0v[8], n1v[8];
      unpack8(*(const bf16x8*)(P + F_RKV + t * 1536 + 1024 + ch), vv);
      if (pos > 0) unpack8(*(const bf16x8*)(P + F_RKV + (t - 1) * 1536 + 1024 + ch), n0v);
      else {
#pragma unroll
        for (int i = 0; i < 8; ++i) n0v[i] = 0.f;
      }
      if (pos < L - 1) unpack8(*(const bf16x8*)(P + F_RKV + (t + 1) * 1536 + 1024 + ch), n1v);
      else {
#pragma unroll
        for (int i = 0; i < 8; ++i) n1v[i] = 0.f;
      }
      const float cf0 = COEF[(t * 8 + head) * 2], cf1 = COEF[(t * 8 + head) * 2 + 1];
      const float* mu0 = p->rwkv_mu + (size_t)(l * 2) * 1664 + 1024 + ch;
      const float* mu1 = p->rwkv_mu + (size_t)(l * 2 + 1) * 1664 + 1024 + ch;
      const float* lg = p->rwkv_lnx_g + l * 512 + ch;
      const float* lb = p->rwkv_lnx_b + l * 512 + ch;
      float z[8];
#pragma unroll
      for (int i = 0; i < 8; ++i) {
        const float vs0 = vv[i] + mu0[i] * (n0v[i] - vv[i]);
        const float vs1 = vv[i] + mu1[i] * (n1v[i] - vv[i]);
        z[i] = y0[i] * rs * lg[i] + lb[i] + cf0 * vs0 + cf1 * vs1;
      }
      *(bf16x8*)(Zs + tok * 136 + hd * 64 + sub * 8) = pack8(z);
    }
    ASig al{P + F_GD + (size_t)m0 * 128, 128};
    f32x4 acc[2][4]; zero_acc<2>(acc);
    gemm_mainloop<2>(acc, al, W + W_G2 + (size_t)c0 * 128, 128, 128, As, Bs);
    u16* dst = Y + (size_t)m0 * 512 + c0;
    epi_bf16<2>(acc, As, dst, 512, [&](int r, int c, float v) { return v * bf2f(Zs[r * 136 + c]); });
    {
      const float* xr0 = (l == 0) ? (m0 < TCTX ? p->x_prompt + (size_t)m0 * 1024 : p->x_sample + (size_t)(m0 - TCTX) * 1024) : p->out + (size_t)m0 * 1024;
      const float* mod = (const float*)(p->ws + OFF_MOD) + (size_t)(l * 9 + cv_of(m0)) * 6144;
      u16* Pw = (u16*)(p->ws + OFF_P);
#pragma unroll 4
      for (int i = 0; i < 8; ++i) {
        const int c = tid + i * 256, row = c >> 5, cc = c & 31;
        const int hcol = (cc < 16) ? c0 + cc * 8 : 512 + c0 + (cc - 16) * 8;
        bf16x8 hv;
        if (l == 0) { AModX al{xr0, mod + 1024, mod}; hv = al(row, hcol); }
        else {
          const float2 ms = *(const float2*)((const float*)(p->ws + OFF_ST) + (size_t)TT * 2 + ((size_t)m0 + row) * 2);
          const float* xr = xr0 + (size_t)row * 1024 + hcol;
          const float* lg = p->ln2_g + hcol; const float* lb = p->ln2_b + hcol;
          float f[8];
#pragma unroll
          for (int e = 0; e < 8; ++e) {
            const float xv = (xr[e] - ms.x) * ms.y * lg[e] + lb[e];
            f[e] = xv * (1.f + mod[1024 + hcol + e]) + mod[hcol + e];
          }
          hv = pack8(f);
        }
        u16* d = (cc < 16) ? Pw + F_VA + ((size_t)m0 + row) * 512 + c0 + cc * 8 : Y + (size_t)TT * 512 + ((size_t)m0 + row) * 512 + c0 + (cc - 16) * 8;
        *(bf16x8*)d = hv;
      }
    }
  }
}

DEV void phase_merge1(PPtr p, int l, unsigned char* smem) {
  u16* Ct = (u16*)(smem + 32768);
  u16* P = (u16*)(p->ws + OFF_P);
  const u16* W = (const u16*)(p->ws + OFF_W);
  const u16* Y = (const u16*)(p->ws + OFF_Y);
  const u16* HLO = P + F_VA;
  const u16* HHI = Y + (size_t)TT * 512;
  u16* MIX = P + F_RKV;
  TQ tq{(unsigned*)(p->ws + OFF_GQ) + (l * 5 + 1) * 128, 192 * 8, xcc_id(), 0};
  int* slot = (int*)(smem + SMEM_BYTES - 16);
  const int tidq = tid_();
  bool pre = false;
  int id = tq_pull(tq, slot, tidq);
  while (id >= 0) {
    int mt, nt; tile_map(id, 8, mt, nt);
    const int m0 = mt * 128, n0 = nt * 128;
    const int idn = tq_pull(tq, slot, tidq); const bool hn = idn >= 0;
    int mtn = 0, ntn = 0; if (hn) tile_map(idn, 8, mtn, ntn);
    f32x4 mix[4][4]; zero_acc<4>(mix);
#pragma unroll 1
    for (int j = 0; j < 3; ++j) {
      const u16* br = ((j == 0) ? P + F_UA : (j == 1) ? P + F_Q : Y) + (size_t)m0 * 512;
      const u16* wb = W + W_BR + ((size_t)j * 1024 + n0) * 512;
      unsigned sg[4][4][2];
      {
        f32x4 accG[4][4]; zero_acc<4>(accG);
        const u16* wg = W + W_IN + ((size_t)3712 + j * 1024 + n0) * 1024;
        gemm_mainloop_dma<4>(accG, HLO + (size_t)m0 * 512, 512, wg, 1024, 512, smem, pre || j > 0, HHI + (size_t)m0 * 512, 512, wg + 512, 1024);
        gemm_mainloop_dma<4>(accG, HHI + (size_t)m0 * 512, 512, wg + 512, 1024, 512, smem, true, br, 512, wb, 512);
#pragma unroll
        for (int m = 0; m < 4; ++m)
#pragma unroll
          for (int n = 0; n < 4; ++n) {
            sg[m][n][0] = pk2(sigmoidf_(accG[m][n][0]), sigmoidf_(accG[m][n][1]));
            sg[m][n][1] = pk2(sigmoidf_(accG[m][n][2]), sigmoidf_(accG[m][n][3]));
          }
      }
      const u16* nA; const u16* nB;
      if (j < 2) { nA = HLO + (size_t)m0 * 512; nB = W + W_IN + ((size_t)3712 + (j + 1) * 1024 + n0) * 1024; }
      else { nA = hn ? HLO + (size_t)mtn * 128 * 512 : nullptr; nB = W + W_IN + ((size_t)3712 + ntn * 128) * 1024; }
      f32x4 accP[4][4]; zero_acc<4>(accP);
      gemm_mainloop_dma<4, false>(accP, br, 512, wb, 512, 512, smem, true, nA, 512, nB, 1024);
#pragma unroll
      for (int m = 0; m < 4; ++m)
#pragma unroll
        for (int n = 0; n < 4; ++n) {
          mix[m][n][0] += __uint_as_float(sg[m][n][0] << 16) * accP[m][n][0];
          mix[m][n][1] += __uint_as_float(sg[m][n][0] & 0xffff0000u) * accP[m][n][1];
          mix[m][n][2] += __uint_as_float(sg[m][n][1] << 16) * accP[m][n][2];
          mix[m][n][3] += __uint_as_float(sg[m][n][1] & 0xffff0000u) * accP[m][n][3];
        }
    }
    pre = hn;
    u16* dst = MIX + (size_t)m0 * 1024 + n0;
    epi_bf16<4>(mix, Ct, dst, 1024, [](int, int, float v) { return v; });
    id = idn;
  }
}

DEV void phase_merge2(PPtr p, int l, unsigned char* smem) {
  const u16* P = (const u16*)(p->ws + OFF_P);
  const u16* W = (const u16*)(p->ws + OFF_W);
  const float* MOD = (const float*)(p->ws + OFF_MOD);
  const u16* MIX = P + F_RKV;
  TQ tq{(unsigned*)(p->ws + OFF_GQ) + (l * 5 + 2) * 128, 192 * 8, xcc_id(), 0};
  int* slot = (int*)(smem + SMEM_BYTES - 16);
  const int tidq = tid_();
  bool pre = false;
  int id = tq_pull(tq, slot, tidq);
  while (id >= 0) {
    int mt, nt; tile_map(id, 8, mt, nt);
    const int m0 = mt * 128, n0 = nt * 128;
    const int idn = tq_pull(tq, slot, tidq); const bool hn = idn >= 0;
    int mtn = 0, ntn = 0; if (hn) tile_map(idn, 8, mtn, ntn);
    const float* xrow0 = (l == 0) ? (m0 < TCTX ? p->x_prompt + (size_t)m0 * 1024 : p->x_sample + (size_t)(m0 - TCTX) * 1024) : p->out + (size_t)m0 * 1024;
    const float* g1 = MOD + (size_t)(l * 9 + cv_of(m0)) * 6144 + 2048 + n0;
    f32x4 acc[4][4]; zero_acc<4>(acc);
    gemm_mainloop_dma<4>(acc, MIX + (size_t)m0 * 1024, 1024, W + W_OUT + (size_t)n0 * 1024, 1024, 1024, smem, pre,
                         hn ? MIX + (size_t)mtn * 128 * 1024 : nullptr, 1024, W + W_OUT + (size_t)ntn * 128 * 1024, 1024);
    pre = hn;
    float* dst = p->out + (size_t)m0 * 1024 + n0;
    const float* xs = xrow0 + n0;
    const float* st2 = (const float*)(p->ws + OFF_ST) + (size_t)TT * 2 + (size_t)m0 * 2;
    const float* lng = p->ln2_g + n0; const float* lnb = p->ln2_b + n0;
    epi_f32(acc, (float*)(smem + 32768), [&](int r, int c, float4 a) {
      float4 x4 = *(const float4*)(xs + (size_t)r * 1024 + c);
      const float4 g4 = *(const float4*)(g1 + c);
      if (l == 1) {
        const float2 ms = *(const float2*)(st2 + r * 2);
        const float4 lg = *(const float4*)(lng + c), lb = *(const float4*)(lnb + c);
        x4 = make_float4((x4.x - ms.x) * ms.y * lg.x + lb.x, (x4.y - ms.x) * ms.y * lg.y + lb.y, (x4.z - ms.x) * ms.y * lg.z + lb.z, (x4.w - ms.x) * ms.y * lg.w + lb.w);
      }
      *(float4*)(dst + (size_t)r * 1024 + c) = make_float4(ALPHA * x4.x + g4.x * a.x, ALPHA * x4.y + g4.y * a.y, ALPHA * x4.z + g4.z * a.z, ALPHA * x4.w + g4.w * a.w);
    });
    id = idn;
  }
}

DEV void phase_ln(PPtr p, const float* g, const float* bta, const float* modl, int sc_off, int sh_off, float* stats) {
  const int tid = tid_(); const int lane = tid & 63, wave = tid >> 6;
  float4 nv[4];
  {
    const float* r0 = p->out + (size_t)(blockIdx.x * 4 + wave) * 1024;
#pragma unroll
    for (int i = 0; i < 4; ++i) nv[i] = *(const float4*)(r0 + (i * 64 + lane) * 4);
  }
  for (int u = blockIdx.x; u < TT / 4; u += gridDim.x) {
    float* row = p->out + (size_t)(u * 4 + wave) * 1024;
    float4 v[4];
    float sum = 0.f;
#pragma unroll
    for (int i = 0; i < 4; ++i) { v[i] = nv[i]; sum += v[i].x + v[i].y + v[i].z + v[i].w; }
    if (u + (int)gridDim.x < TT / 4) {
      const float* rn = row + (size_t)gridDim.x * 4 * 1024;
#pragma unroll
      for (int i = 0; i < 4; ++i) nv[i] = *(const float4*)(rn + (i * 64 + lane) * 4);
    }
    sum = wave_sum(sum, lane);
    const float mu = sum * (1.f / 1024.f);
    float sq = 0.f;
#pragma unroll
    for (int i = 0; i < 4; ++i) {
      v[i].x -= mu; v[i].y -= mu; v[i].z -= mu; v[i].w -= mu;
      sq += v[i].x * v[i].x + v[i].y * v[i].y + v[i].z * v[i].z + v[i].w * v[i].w;
    }
    sq = wave_sum(sq, lane);
    const float rs = rsqrtf(sq * (1.f / 1024.f) + 1e-5f);
    if (stats && lane == 0) *(float2*)(stats + (size_t)(u * 4 + wave) * 2) = make_float2(mu, rs);
#pragma unroll
    for (int i = 0; i < 4; ++i) {
      const int c = (i * 64 + lane) * 4;
      float4 gg = *(const float4*)(g + c), bb = *(const float4*)(bta + c);
      float4 o4 = make_float4(v[i].x * rs * gg.x + bb.x, v[i].y * rs * gg.y + bb.y, v[i].z * rs * gg.z + bb.z, v[i].w * rs * gg.w + bb.w);
      if (!stats) *(float4*)(row + c) = o4;
      if (modl) {
        const float* mrow = modl + (size_t)cv_of(u * 4 + wave) * 6144;
        const float4 s4 = *(const float4*)(mrow + sc_off + c), h4 = *(const float4*)(mrow + sh_off + c);
        uint2 hv;
        hv.x = pk2(o4.x * (1.f + s4.x) + h4.x, o4.y * (1.f + s4.y) + h4.y);
        hv.y = pk2(o4.z * (1.f + s4.z) + h4.z, o4.w * (1.f + s4.w) + h4.w);
        *(uint2*)((u16*)(p->ws + OFF_H) + (size_t)(u * 4 + wave) * 1024 + c) = hv;
      }
    }
  }
}

DEV void phase_ffn1(PPtr p, int l, unsigned char* smem) {
  u16* Ct = (u16*)(smem + 32768);
  const u16* W = (const u16*)(p->ws + OFF_W);
  const u16* H = (const u16*)(p->ws + OFF_H);
  u16* HID = (u16*)(p->ws + OFF_HID);
  TQ tq{(unsigned*)(p->ws + OFF_GQ) + (l * 5 + 3) * 128, 192 * 32, xcc_id(), 0};
  int* slot = (int*)(smem + SMEM_BYTES - 16);
  const int tidq = tid_();
  bool pre = false;
  int id = tq_pull(tq, slot, tidq);
  while (id >= 0) {
    int mt, nt; tile_map(id, 32, mt, nt);
    const int m0 = mt * 128, n0 = nt * 128;
    const int idn = tq_pull(tq, slot, tidq); const bool hn = idn >= 0;
    int mtn = 0, ntn = 0; if (hn) tile_map(idn, 32, mtn, ntn);
    f32x4 acc[4][4]; zero_acc<4>(acc);
    gemm_mainloop_dma<4>(acc, H + (size_t)m0 * 1024, 1024, W + W_UP + (size_t)n0 * 1024, 1024, 1024, smem, pre,
                         hn ? H + (size_t)mtn * 128 * 1024 : nullptr, 1024, W + W_UP + (size_t)ntn * 128 * 1024, 1024);
    pre = hn;
    u16* dst = HID + (size_t)m0 * 4096 + n0;
    epi_bf16<4>(acc, Ct, dst, 4096, [](int, int, float v) { float q = fmaxf(v, 0.f); return q * q; });
    id = idn;
  }
}

DEV void phase_ffn2(PPtr p, int l, unsigned char* smem) {
  const u16* W = (const u16*)(p->ws + OFF_W);
  const float* MOD = (const float*)(p->ws + OFF_MOD);
  const u16* HID = (const u16*)(p->ws + OFF_HID);
  TQ tq{(unsigned*)(p->ws + OFF_GQ) + (l * 5 + 4) * 128, 192 * 8, xcc_id(), 0};
  int* slot = (int*)(smem + SMEM_BYTES - 16);
  const int tidq = tid_();
  bool pre = false;
  int id = tq_pull(tq, slot, tidq);
  while (id >= 0) {
    int mt, nt; tile_map(id, 8, mt, nt);
    const int m0 = mt * 128, n0 = nt * 128;
    const int idn = tq_pull(tq, slot, tidq); const bool hn = idn >= 0;
    int mtn = 0, ntn = 0; if (hn) tile_map(idn, 8, mtn, ntn);
    const float* g2 = MOD + (size_t)(l * 9 + cv_of(m0)) * 6144 + 5120 + n0;
    f32x4 acc[4][4]; zero_acc<4>(acc);
    gemm_mainloop_dma<4>(acc, HID + (size_t)m0 * 4096, 4096, W + W_DOWN + (size_t)n0 * 4096, 4096, 4096, smem, pre,
                         hn ? HID + (size_t)mtn * 128 * 4096 : nullptr, 4096, W + W_DOWN + (size_t)ntn * 128 * 4096, 4096);
    pre = hn;
    float* dst = p->out + (size_t)m0 * 1024 + n0;
    const float* st1 = (const float*)(p->ws + OFF_ST) + (size_t)m0 * 2;
    const float* lng = p->ln1_g + l * 1024 + n0; const float* lnb = p->ln1_b + l * 1024 + n0;
    epi_f32(acc, (float*)(smem + 32768), [&](int r, int c, float4 a) {
      float* e = dst + (size_t)r * 1024 + c;
      const float2 ms = *(const float2*)(st1 + r * 2);
      const float4 y4 = *(const float4*)e, g4 = *(const float4*)(g2 + c), lg = *(const float4*)(lng + c), lb = *(const float4*)(lnb + c);
      const float4 x4 = make_float4((y4.x - ms.x) * ms.y * lg.x + lb.x, (y4.y - ms.x) * ms.y * lg.y + lb.y, (y4.z - ms.x) * ms.y * lg.z + lb.z, (y4.w - ms.x) * ms.y * lg.w + lb.w);
      *(float4*)e = make_float4(ALPHA * x4.x + g4.x * a.x, ALPHA * x4.y + g4.y * a.y, ALPHA * x4.z + g4.z * a.z, ALPHA * x4.w + g4.w * a.w);
    });
    id = idn;
  }
}

__global__ void __launch_bounds__(NTHR, 2) fwd_megakernel(Params p_unused) {
  __shared__ __attribute__((aligned(16))) unsigned char smem[SMEM_BYTES];
  cg::grid_group grid = cg::this_grid();
  PPtr kp = (PPtr)__builtin_amdgcn_kernarg_segment_ptr();
#define p launder_p(kp)
  {
    unsigned* st0 = (unsigned*)(smem + SMEM_BYTES - 8);
    if (tid_() == 0) {
      st0[0] = 0u; st0[1] = 0u;
      const unsigned x = (unsigned)__builtin_amdgcn_s_getreg((3 << 11) | 20) & 0xFu;
      (void)xb_add((unsigned*)(p->ws + OFF_XB) + XB_XCNT(x), 1u);
    }
    __syncthreads();
  }
#define MODP ((const float*)(p->ws + OFF_MOD))
#pragma unroll 1
  for (int step = 0; step < 21; ++step) {
    const int l = (step - 1) / 10, ph = (step - 1) % 10;
    if (step == 0) {
      for (int u = blockIdx.x; u < 192; u += gridDim.x) mod_unit(p, u, (float*)smem);
      if (p->ws == nullptr) grid.sync();
    } else if (ph == 0) { if (l == 0) phase_convert(p, 0, smem); else continue; }
    else if (ph == 1) phase_inproj(p, l, smem);
    else if (ph == 2) phase_mix(p, l, smem);
    else if (ph == 3) phase_fin(p, l, smem);
    else if (ph == 4) phase_merge1(p, l, smem);
    else if (ph == 5) phase_merge2(p, l, smem);
    else if (ph == 6) phase_ln(p, p->ln1_g + l * 1024, p->ln1_b + l * 1024, MODP + (size_t)l * 9 * 6144, 4096, 3072, (float*)(p->ws + OFF_ST));
    else if (ph == 7) phase_ffn1(p, l, smem);
    else if (ph == 8) phase_ffn2(p, l, smem);
    else {
      phase_ln(p, p->ln2_g + l * 1024, p->ln2_b + l * 1024, l == 0 ? MODP + (size_t)9 * 6144 : nullptr, 1024, 0, l == 0 ? (float*)(p->ws + OFF_ST) + (size_t)TT * 2 : nullptr);
      if (l == 0) phase_convert(p, 1, smem); else break;
    }
    gbar((unsigned*)(p->ws + OFF_XB), smem);
  }
}
#undef MODP
#undef p

extern "C" void kernel_launch(void* const* d_in, const int* in_sizes, int n_in, void* d_out, int out_size, void* d_ws,
                              size_t ws_size, hipStream_t stream) {
  static int grid_blocks = 0;
  if (!grid_blocks) {
    if (n_in != 35 || ws_size < WS_END) { fprintf(stderr, "kernel_launch: bad n_in %d or ws %zu < %zu\n", n_in, ws_size, (size_t)WS_END); grid_blocks = -1; return; }
    int dev = 0, cus = 0, per_cu = 0;
    hipGetDevice(&dev);
    hipDeviceGetAttribute(&cus, hipDeviceAttributeMultiprocessorCount, dev);
    hipOccupancyMaxActiveBlocksPerMultiprocessor(&per_cu, fwd_megakernel, NTHR, 0);
    if (per_cu > 2) per_cu = 2;
    if (per_cu < 1) per_cu = 1;
    grid_blocks = cus * per_cu;
  }
  if (grid_blocks < 0) return;
  hipMemsetAsync((unsigned char*)d_ws + OFF_CUTAB, 0, 65536, stream);
  Params p{};
  const float** pp = (const float**)&p;
  for (int i = 0; i < 35; ++i) pp[i] = (const float*)d_in[i];
  p.out = (float*)d_out;
  p.ws = (unsigned char*)d_ws;
  void* args[] = {&p};
  hipError_t e = hipLaunchCooperativeKernel((void*)fwd_megakernel, dim3(grid_blocks), dim3(NTHR), args, 0, stream);
  if (e != hipSuccess) fprintf(stderr, "cooperative launch failed: %s (grid %d)\n", hipGetErrorString(e), grid_blocks);
}
```

```cpp
#include <hip/hip_runtime.h>
#include <hip/hip_cooperative_groups.h>
#include <cstdio>
namespace cg = cooperative_groups;

typedef unsigned short u16;
typedef __attribute__((ext_vector_type(8))) short bf16x8;
typedef __attribute__((ext_vector_type(4))) short bf16x4;
typedef __attribute__((ext_vector_type(4))) float f32x4;

#define DEV __device__ __forceinline__

constexpr int TCTX = 8192, TLAT = 16384, TT = 24576;
constexpr float ALPHA = 1.41421356237309515f;
constexpr float GN_EPS = 64e-5f;
constexpr int NTHR = 256;

constexpr size_t OFF_MOD = 0;
constexpr size_t OFF_COEF = 524288;
constexpr size_t OFF_CTR = 516096;
constexpr size_t OFF_W = 2101248;
constexpr size_t W_UP = 0, W_DOWN = 4194304, W_IN = 8388608, W_BR = 15335424, W_OUT = 16908288,
                 W_SGU = 17956864, W_W2 = 18022400, W_A2 = 18087936, W_G2 = 18153472, W_TOTAL = 18219008;
constexpr size_t OFF_KC = OFF_W + W_TOTAL * 2;
constexpr size_t KC_LAT = 1048576;
constexpr size_t KC_ELEMS = 3670016;
constexpr size_t OFF_VT = OFF_KC + KC_ELEMS * 2;
constexpr size_t OFF_P = OFF_VT + KC_ELEMS * 2;
constexpr size_t F_UA = 0, F_VA = 12582912, F_Q = 25165824, F_KK = 37748736, F_VV = 40894464, F_RKV = 44040192,
                 F_LORA = 81788928, F_GD = 88080384, P_ELEMS = 91226112;
constexpr size_t OFF_Y = OFF_P + P_ELEMS * 2;
constexpr size_t Y_ELEMS = 25165824;
constexpr size_t OFF_ST = OFF_Y + Y_ELEMS * 2;
constexpr size_t WS_END = OFF_ST + (size_t)2 * TT * 2 * 4;
constexpr size_t OFF_HID = OFF_W + W_IN * 2;
constexpr size_t OFF_H = OFF_Y;
static_assert(OFF_HID + (size_t)TT * 4096 * 2 <= OFF_Y, "HID overlaps H");
constexpr size_t O_NCK = 25165824, O_NCV = 27262976, O_NST = 29360128;

constexpr int SMEM_BYTES = 73728;

struct Params {
  const float *x_prompt, *x_sample, *cache_k, *cache_v, *state_wkv, *c, *c_ctx, *w_ada, *b_ada, *w_in,
      *sgu_ln_g, *sgu_ln_b, *sgu_w, *sgu_b, *q_norm, *k_norm, *rwkv_mu, *rwkv_w0, *rwkv_w2, *rwkv_a0, *rwkv_a2,
      *rwkv_k_k, *rwkv_k_a, *rwkv_r_k, *rwkv_g2, *rwkv_lnx_g, *rwkv_lnx_b, *w_branch, *w_out, *ln1_g, *ln1_b,
      *w_up, *w_down, *ln2_g, *ln2_b;
  float* out;
  unsigned char* ws;
};

typedef __attribute__((ext_vector_type(2))) float f32x2;
typedef __attribute__((ext_vector_type(2))) __bf16 bf16x2_t;
typedef __attribute__((ext_vector_type(4))) unsigned u32x4;
DEV unsigned pk2(float a, float b) { f32x2 v = {a, b}; return __builtin_bit_cast(unsigned, __builtin_convertvector(v, bf16x2_t)); }
DEV u16 f2bf(float f) { return (u16)(pk2(f, 0.f) & 0xffffu); }
DEV float bf2f(u16 h) { return __uint_as_float(((unsigned)h) << 16); }
DEV float bfs(short h) { return __uint_as_float(((unsigned)(u16)h) << 16); }
DEV float frcp(float x) { return __builtin_amdgcn_rcpf(x); }
DEV float sigmoidf_(float x) { return frcp(1.f + __expf(-x)); }
DEV bf16x8 pack8(const float* f) {
  u32x4 r = {pk2(f[0], f[1]), pk2(f[2], f[3]), pk2(f[4], f[5]), pk2(f[6], f[7])};
  return __builtin_bit_cast(bf16x8, r);
}
DEV void unpack8(bf16x8 v, float* f) {
#pragma unroll
  for (int i = 0; i < 8; ++i) f[i] = bfs(v[i]);
}
DEV float dpp_xor1(float x) { return __int_as_float(__builtin_amdgcn_update_dpp(0, __float_as_int(x), 0xB1, 0xF, 0xF, true)); }
DEV float dpp_xor2(float x) { return __int_as_float(__builtin_amdgcn_update_dpp(0, __float_as_int(x), 0x4E, 0xF, 0xF, true)); }
DEV float dpp_hmirror(float x) { return __int_as_float(__builtin_amdgcn_update_dpp(0, __float_as_int(x), 0x141, 0xF, 0xF, true)); }
DEV float dpp_mirror(float x) { return __int_as_float(__builtin_amdgcn_update_dpp(0, __float_as_int(x), 0x140, 0xF, 0xF, true)); }
DEV float shx(float v, int mask, int lane) { return __int_as_float(__builtin_amdgcn_ds_bpermute((lane ^ mask) << 2, __float_as_int(v))); }
DEV float wave_sum(float x, int lane) {
  x += dpp_xor1(x); x += dpp_xor2(x); x += dpp_hmirror(x); x += dpp_mirror(x);
  x += shx(x, 16, lane); x += shx(x, 32, lane);
  return x;
}
DEV f32x4 mfma16(bf16x8 a, bf16x8 b, f32x4 c) { return __builtin_amdgcn_mfma_f32_16x16x32_bf16(a, b, c, 0, 0, 0); }

typedef const __attribute__((address_space(4))) Params* PPtr;
DEV PPtr launder_p(PPtr q) { asm volatile("" : "+s"(q)); return q; }
DEV int tid_() { int t = threadIdx.x; asm volatile("" : "+v"(t)); return t; }
DEV int cv_of(int t) { return t < TCTX ? 0 : 1 + ((t - TCTX) >> 11); }

struct ABf16 {
  const u16* base; int ld;
  DEV bf16x8 operator()(int row, int k) const { return *(const bf16x8*)(base + (size_t)row * ld + k); }
};
struct ASig {
  const u16* base; int ld;
  DEV bf16x8 operator()(int row, int k) const {
    bf16x8 v = *(const bf16x8*)(base + (size_t)row * ld + k);
    float f[8]; unpack8(v, f);
#pragma unroll
    for (int i = 0; i < 8; ++i) f[i] = sigmoidf_(f[i]);
    return pack8(f);
  }
};
struct AModX {
  const float* xrow0; const float* sc; const float* sh;
  DEV bf16x8 operator()(int row, int k) const {
    const float* xr = xrow0 + (size_t)row * 1024 + k;
    float4 x0 = *(const float4*)xr, x1 = *(const float4*)(xr + 4);
    float4 s0 = *(const float4*)(sc + k), s1 = *(const float4*)(sc + k + 4);
    float4 h0 = *(const float4*)(sh + k), h1 = *(const float4*)(sh + k + 4);
    float f[8];
    f[0] = x0.x * (1.f + s0.x) + h0.x; f[1] = x0.y * (1.f + s0.y) + h0.y;
    f[2] = x0.z * (1.f + s0.z) + h0.z; f[3] = x0.w * (1.f + s0.w) + h0.w;
    f[4] = x1.x * (1.f + s1.x) + h1.x; f[5] = x1.y * (1.f + s1.y) + h1.y;
    f[6] = x1.z * (1.f + s1.z) + h1.z; f[7] = x1.w * (1.f + s1.w) + h1.w;
    return pack8(f);
  }
};

template <int MT, class AL>
DEV void gemm_mainloop(f32x4 (&acc)[MT][4], const AL& aload, const u16* __restrict__ Bt, int ldb, int K, u16* As, u16* Bs) {
  const int tid = tid_(), lane = tid & 63, wave = tid >> 6;
  const int wr = wave >> 1, wc = wave & 1, l15 = lane & 15, quad = lane >> 4;
  bf16x8 ra[MT], rb[4];
#pragma unroll
  for (int i = 0; i < MT; ++i) { int c = tid + i * 256; ra[i] = aload(c >> 3, (c & 7) * 8); }
#pragma unroll
  for (int i = 0; i < 4; ++i) { int c = tid + i * 256; rb[i] = *(const bf16x8*)(Bt + (size_t)(c >> 3) * ldb + (c & 7) * 8); }
  const int nk = K >> 6;
#pragma unroll 1
  for (int kt = 0; kt < nk; ++kt) {
    __syncthreads();
#pragma unroll
    for (int i = 0; i < MT; ++i) { int c = tid + i * 256; *(bf16x8*)(As + (c >> 3) * 72 + (c & 7) * 8) = ra[i]; }
#pragma unroll
    for (int i = 0; i < 4; ++i) { int c = tid + i * 256; *(bf16x8*)(Bs + (c >> 3) * 72 + (c & 7) * 8) = rb[i]; }
    __syncthreads();
    if (kt + 1 < nk) {
      const int k0 = (kt + 1) << 6;
#pragma unroll
      for (int i = 0; i < MT; ++i) { int c = tid + i * 256; ra[i] = aload(c >> 3, k0 + (c & 7) * 8); }
#pragma unroll
      for (int i = 0; i < 4; ++i) { int c = tid + i * 256; rb[i] = *(const bf16x8*)(Bt + (size_t)(c >> 3) * ldb + k0 + (c & 7) * 8); }
    }
#pragma unroll
    for (int ks = 0; ks < 2; ++ks) {
      bf16x8 a[MT], b[4];
#pragma unroll
      for (int m = 0; m < MT; ++m) a[m] = *(const bf16x8*)(As + (wr * MT * 16 + m * 16 + l15) * 72 + ks * 32 + quad * 8);
#pragma unroll
      for (int n = 0; n < 4; ++n) b[n] = *(const bf16x8*)(Bs + (wc * 64 + n * 16 + l15) * 72 + ks * 32 + quad * 8);
#pragma unroll
      for (int m = 0; m < MT; ++m)
#pragma unroll
        for (int n = 0; n < 4; ++n) acc[m][n] = mfma16(a[m], b[n], acc[m][n]);
    }
  }
}

template <int MT, bool HOIST = true>
DEV void gemm_mainloop_dma(f32x4 (&acc)[MT][4], const u16* __restrict__ A, int lda, const u16* __restrict__ Bt, int ldb, int K, unsigned char* smem,
                           bool pre = false, const u16* nA = nullptr, int nlda = 0, const u16* nBt = nullptr, int nldb = 0) {
  const int tid = tid_(), lane = tid & 63, wave = tid >> 6;
  const int wr = wave >> 1, wc = wave & 1, l15 = lane & 15, quad = lane >> 4;
  const int prow = tid >> 3, pkc = ((tid & 7) ^ ((tid >> 3) & 7)) * 8;
  const u16* ga = A + (size_t)prow * lda + pkc;
  const u16* gb = Bt + (size_t)prow * ldb + pkc;
  const int nk = K >> 6;
  const int sw = l15 & 7;
  const int slot0 = ((quad) ^ sw) * 16, slot1 = ((4 + quad) ^ sw) * 16;
  const int arow = (wr * MT * 16 + l15) * 128, brow = (wc * 64 + l15) * 128;
  if (!pre) {
    __syncthreads();
    unsigned char* sa = smem + tid * 16;
#pragma unroll
    for (int i = 0; i < MT; ++i) __builtin_amdgcn_global_load_lds((const unsigned*)(ga + (size_t)i * 32 * lda), (unsigned*)(sa + i * 4096), 16, 0, 0);
#pragma unroll
    for (int i = 0; i < 4; ++i) __builtin_amdgcn_global_load_lds((const unsigned*)(gb + (size_t)i * 32 * ldb), (unsigned*)(sa + 16384 + i * 4096), 16, 0, 0);
  }
#pragma unroll 1
  for (int kt = 0; kt < nk; ++kt) {
    asm volatile("s_waitcnt vmcnt(0)" ::: "memory");
    __syncthreads();
    if (kt + 1 < nk) {
      unsigned char* sa = smem + ((kt + 1) & 1) * 32768 + tid * 16;
      const int k0 = (kt + 1) << 6;
#pragma unroll
      for (int i = 0; i < MT; ++i) __builtin_amdgcn_global_load_lds((const unsigned*)(ga + (size_t)i * 32 * lda + k0), (unsigned*)(sa + i * 4096), 16, 0, 0);
#pragma unroll
      for (int i = 0; i < 4; ++i) __builtin_amdgcn_global_load_lds((const unsigned*)(gb + (size_t)i * 32 * ldb + k0), (unsigned*)(sa + 16384 + i * 4096), 16, 0, 0);
    } else if (nA) {
      unsigned char* sa = smem + tid * 16;
      const u16* na = nA + (size_t)prow * nlda + pkc;
      const u16* nb = nBt + (size_t)prow * nldb + pkc;
#pragma unroll
      for (int i = 0; i < MT; ++i) __builtin_amdgcn_global_load_lds((const unsigned*)(na + (size_t)i * 32 * nlda), (unsigned*)(sa + i * 4096), 16, 0, 0);
#pragma unroll
      for (int i = 0; i < 4; ++i) __builtin_amdgcn_global_load_lds((const unsigned*)(nb + (size_t)i * 32 * nldb), (unsigned*)(sa + 16384 + i * 4096), 16, 0, 0);
    }
    const unsigned char* ab = smem + (kt & 1) * 32768;
    const unsigned char* bb = ab + 16384;
    if (!HOIST) {
#pragma unroll
      for (int ks = 0; ks < 2; ++ks) {
        const int slot = ks ? slot1 : slot0;
        bf16x8 a[MT], b[4];
#pragma unroll
        for (int m = 0; m < MT; ++m) a[m] = *(const bf16x8*)(ab + arow + m * 2048 + slot);
#pragma unroll
        for (int n = 0; n < 4; ++n) b[n] = *(const bf16x8*)(bb + brow + n * 2048 + slot);
        __builtin_amdgcn_sched_barrier(0);
#pragma unroll
        for (int m = 0; m < MT; ++m)
#pragma unroll
          for (int n = 0; n < 4; ++n) acc[m][n] = mfma16(a[m], b[n], acc[m][n]);
        __builtin_amdgcn_sched_barrier(0);
      }
      continue;
    }
    bf16x8 a0[MT], b0[4], a1[MT], b1[4];
#pragma unroll
    for (int m = 0; m < MT; ++m) a0[m] = *(const bf16x8*)(ab + arow + m * 2048 + slot0);
#pragma unroll
    for (int n = 0; n < 4; ++n) b0[n] = *(const bf16x8*)(bb + brow + n * 2048 + slot0);
#pragma unroll
    for (int m = 0; m < MT; ++m) a1[m] = *(const bf16x8*)(ab + arow + m * 2048 + slot1);
#pragma unroll
    for (int n = 0; n < 4; ++n) b1[n] = *(const bf16x8*)(bb + brow + n * 2048 + slot1);
    __builtin_amdgcn_sched_barrier(0);
#pragma unroll
    for (int m = 0; m < MT; ++m)
#pragma unroll
      for (int n = 0; n < 4; ++n) acc[m][n] = mfma16(a0[m], b0[n], acc[m][n]);
#pragma unroll
    for (int m = 0; m < MT; ++m)
#pragma unroll
      for (int n = 0; n < 4; ++n) acc[m][n] = mfma16(a1[m], b1[n], acc[m][n]);
  }
}

template <int MT>
DEV void zero_acc(f32x4 (&acc)[MT][4]) {
#pragma unroll
  for (int m = 0; m < MT; ++m)
#pragma unroll
    for (int n = 0; n < 4; ++n) acc[m][n] = (f32x4){0.f, 0.f, 0.f, 0.f};
}

template <int MT, class F>
DEV void epi_foreach(f32x4 (&acc)[MT][4], F f) {
  const int tid = tid_(); const int lane = tid & 63, wave = tid >> 6;
  const int wr = wave >> 1, wc = wave & 1, l15 = lane & 15, quad = lane >> 4;
#pragma unroll
  for (int m = 0; m < MT; ++m)
#pragma unroll
    for (int n = 0; n < 4; ++n)
#pragma unroll
      for (int j = 0; j < 4; ++j) f(wr * MT * 16 + m * 16 + quad * 4 + j, wc * 64 + n * 16 + l15, acc[m][n][j]);
}

template <int MT, class F>
DEV void epi_bf16(f32x4 (&acc)[MT][4], u16* Ct, u16* dst, int ld, F f) {
  __syncthreads();
  epi_foreach<MT>(acc, [&](int r, int c, float v) { Ct[r * 136 + c] = f2bf(f(r, c, v)); });
  __syncthreads();
  const int tid = tid_();
#pragma unroll
  for (int i = 0; i < MT * 2; ++i) {
    const int c = tid + i * 256, row = c >> 4, cc = (c & 15) * 8;
    *(bf16x8*)(dst + (size_t)row * ld + cc) = *(const bf16x8*)(Ct + row * 136 + cc);
  }
}
template <class G>
DEV void epi_f32(f32x4 (&acc)[4][4], float* Cf, G g) {
  const int tid = tid_(), lane = tid & 63, wave = tid >> 6;
  const int wr = wave >> 1, wc = wave & 1, l15 = lane & 15, quad = lane >> 4;
#pragma unroll 1
  for (int half = 0; half < 2; ++half) {
    __syncthreads();
    if (wr == half) {
#pragma unroll
      for (int m = 0; m < 4; ++m)
#pragma unroll
        for (int n = 0; n < 4; ++n)
#pragma unroll
          for (int j = 0; j < 4; ++j) Cf[(m * 16 + quad * 4 + j) * 132 + wc * 64 + n * 16 + l15] = acc[m][n][j];
    }
    __syncthreads();
#pragma unroll 4
    for (int i = 0; i < 8; ++i) {
      const int c = tid + i * 256, row = c >> 5, cc = (c & 31) * 4;
      g(half * 64 + row, cc, *(const float4*)(Cf + row * 132 + cc));
    }
  }
}

#define XB_TMO 128
#define XB_XCNT(j) (256 + 64 * (j))
#define XB_XSUB(j) (1280 + 64 * (j))
#define XB_XGEN(j) (2304 + 64 * (j))
#define XB_TOP 3328
#define XB_TOPGEN 3392
#define XB_SPIN_CAP (1u << 20)
constexpr size_t OFF_XB = 499712;
DEV unsigned xb_ld(unsigned* q) { return __hip_atomic_load(q, __ATOMIC_RELAXED, __HIP_MEMORY_SCOPE_AGENT); }
DEV unsigned xb_add(unsigned* q, unsigned v) { return __hip_atomic_fetch_add(q, v, __ATOMIC_RELAXED, __HIP_MEMORY_SCOPE_AGENT); }
#define XB_SPIN(cond, bar)                                                                                         \
  do {                                                                                                             \
    unsigned _sp = 0;                                                                                              \
    while (cond) {                                                                                                 \
      __builtin_amdgcn_s_sleep(1);                                                                                 \
      if ((++_sp & 255u) == 0u) { if (xb_ld(&(bar)[XB_TMO])) break; if (_sp > XB_SPIN_CAP) { atomicAdd(&(bar)[XB_TMO], 1u); break; } } \
    }                                                                                                              \
  } while (0)
DEV void xb_complete(unsigned* bar, unsigned x, unsigned& nloc, unsigned& nx) {
  const unsigned G = gridDim.x;
  unsigned sum, cnt, mine, sp = 0u;
  for (;;) {
    sum = 0u; cnt = 0u; mine = 0u;
#pragma unroll 1
    for (unsigned j = 0; j < 16; ++j) { const unsigned c = xb_ld(&bar[XB_XCNT(j)]); sum += c; cnt += (c > 0u) ? 1u : 0u; mine = (j == x) ? c : mine; }
    if (sum == G) break;
    __builtin_amdgcn_s_sleep(1);
    if ((++sp & 255u) == 0u) { if (xb_ld(&bar[XB_TMO])) break; if (sp > XB_SPIN_CAP) { atomicAdd(&bar[XB_TMO], 1u); break; } }
  }
  nloc = mine > 0u ? mine : 1u; nx = cnt > 0u ? cnt : 1u;
}
DEV void gbar(unsigned* bar, unsigned char* smem) {
  unsigned* st = (unsigned*)(smem + SMEM_BYTES - 8);
  asm volatile("s_waitcnt vmcnt(0)" ::: "memory");
  __syncthreads();
  if (tid_() == 0) {
    __builtin_amdgcn_s_waitcnt(0);
    const unsigned x = (unsigned)__builtin_amdgcn_s_getreg((3 << 11) | 20) & 0xFu;
    unsigned nloc = st[0], nx = st[1];
    if (nloc == 0u) { xb_complete(bar, x, nloc, nx); st[0] = nloc; st[1] = nx; }
    const unsigned old = xb_add(&bar[XB_XSUB(x)], 1u);
    const unsigned gen = old / nloc;
    if (old + 1u == (gen + 1u) * nloc) {
      __builtin_amdgcn_fence(__ATOMIC_RELEASE, "agent");
      asm volatile("s_waitcnt vmcnt(0)" ::: "memory");
      const unsigned og = xb_add(&bar[XB_TOP], 1u);
      const unsigned tg = og / nx;
      if (og + 1u == (tg + 1u) * nx) xb_add(&bar[XB_TOPGEN], 1u);
      else XB_SPIN(xb_ld(&bar[XB_TOPGEN]) == tg, bar);
      __builtin_amdgcn_fence(__ATOMIC_ACQUIRE, "agent");
      xb_add(&bar[XB_XGEN(x)], 1u);
      asm volatile("s_waitcnt vmcnt(0)" ::: "memory");
    } else {
      XB_SPIN(xb_ld(&bar[XB_XGEN(x)]) == gen, bar);
      __builtin_amdgcn_fence(__ATOMIC_ACQUIRE, "agent");
      asm volatile("s_waitcnt vmcnt(0)" ::: "memory");
    }
  }
  __syncthreads();
}

DEV void transpose_tile(const float* __restrict__ src, int K, int N, u16* __restrict__ dst, int tile, float* sm) {
  const int tn = N >> 6;
  const int k0 = (tile / tn) * 64, n0 = (tile % tn) * 64;
  const int tid = tid_();
  __syncthreads();
#pragma unroll
  for (int i = 0; i < 4; ++i) {
    const int k = i * 16 + (tid >> 4), n = (tid & 15) * 4;
    const float4 v4 = *(const float4*)(src + (size_t)(k0 + k) * N + n0 + n);
    sm[k * 65 + n] = v4.x; sm[k * 65 + n + 1] = v4.y; sm[k * 65 + n + 2] = v4.z; sm[k * 65 + n + 3] = v4.w;
  }
  __syncthreads();
  const int n = tid >> 2, kc = (tid & 3) * 16;
  bf16x8 o0, o1;
#pragma unroll
  for (int i = 0; i < 8; ++i) { o0[i] = (short)f2bf(sm[(kc + i) * 65 + n]); o1[i] = (short)f2bf(sm[(kc + 8 + i) * 65 + n]); }
  u16* d = dst + (size_t)(n0 + n) * K + k0 + kc;
  *(bf16x8*)d = o0; *(bf16x8*)(d + 8) = o1;
}

DEV void mod_unit(PPtr p, int u, float* sm) {
  const int l2 = u / 96, n0 = (u % 96) * 64, tid = tid_();
  float* sc = sm; float* red = sm + 9216;
  __syncthreads();
  for (int i = tid; i < 9216; i += 256) {
    int cv = i >> 10, k = i & 1023;
    float x = cv == 0 ? p->c_ctx[k] : p->c[(cv - 1) * 1024 + k];
    sc[i] = x / (1.f + __expf(-x));
  }
  __syncthreads();
  const int kq = tid >> 6, col = tid & 63;
  float acc[9];
#pragma unroll
  for (int cv = 0; cv < 9; ++cv) acc[cv] = 0.f;
  const float* w = p->w_ada + ((size_t)l2 * 1024 + kq * 256) * 6144 + n0 + col;
#pragma unroll 4
  for (int k = 0; k < 256; ++k) {
    float wv = w[(size_t)k * 6144];
#pragma unroll
    for (int cv = 0; cv < 9; ++cv) acc[cv] += sc[cv * 1024 + kq * 256 + k] * wv;
  }
#pragma unroll
  for (int cv = 0; cv < 9; ++cv) red[(kq * 9 + cv) * 64 + col] = acc[cv];
  __syncthreads();
  float* MOD = (float*)(p->ws + OFF_MOD);
  for (int i = tid; i < 576; i += 256) {
    int cv = i >> 6, cc = i & 63;
    float s = red[(0 * 9 + cv) * 64 + cc] + red[(1 * 9 + cv) * 64 + cc] + red[(2 * 9 + cv) * 64 + cc] + red[(3 * 9 + cv) * 64 + cc];
    MOD[(size_t)(l2 * 9 + cv) * 6144 + n0 + cc] = s + p->b_ada[l2 * 6144 + n0 + cc];
  }
}

DEV void phase_convert(PPtr p, int l, unsigned char* smem) {
  float* sm = (float*)smem;
  u16* W = (u16*)(p->ws + OFF_W);
  const int tidc = tid_();
  const int total = (l == 0) ? 4448 + 1536 : 4448;
  for (int id = blockIdx.x; id < total; id += gridDim.x) {
    if (id < 1696) transpose_tile(p->w_in + (size_t)l * 1024 * 6784, 1024, 6784, W + W_IN, id, sm);
    else if (id < 2080) { int j = (id - 1696) >> 7; transpose_tile(p->w_branch + (size_t)(l * 3 + j) * 512 * 1024, 512, 1024, W + W_BR + (size_t)j * 1024 * 512, (id - 1696) & 127, sm); }
    else if (id < 2336) transpose_tile(p->w_out + (size_t)l * 1024 * 1024, 1024, 1024, W + W_OUT, id - 2080, sm);
    else if (id < 3360) transpose_tile(p->w_up + (size_t)l * 1024 * 4096, 1024, 4096, W + W_UP, id - 2336, sm);
    else if (id < 4384) transpose_tile(p->w_down + (size_t)l * 4096 * 1024, 4096, 1024, W + W_DOWN, id - 3360, sm);
    else if (id < 4400) { int d = (id - 4384) >> 3; transpose_tile(p->rwkv_w2 + (size_t)(l * 2 + d) * 64 * 512, 64, 512, W + W_W2 + (size_t)d * 512 * 64, (id - 4384) & 7, sm); }
    else if (id < 4416) { int d = (id - 4400) >> 3; transpose_tile(p->rwkv_a2 + (size_t)(l * 2 + d) * 64 * 512, 64, 512, W + W_A2 + (size_t)d * 512 * 64, (id - 4400) & 7, sm); }
    else if (id < 4432) transpose_tile(p->rwkv_g2 + (size_t)l * 128 * 512, 128, 512, W + W_G2, id - 4416, sm);
    else if (id < 4448) {
      const float* src = p->sgu_w + (size_t)l * 65536 + (id - 4432) * 4096 + tidc * 16;
      u16* dst = W + W_SGU + (id - 4432) * 4096 + tidc * 16;
      float f[16];
#pragma unroll
      for (int i = 0; i < 4; ++i) { float4 v = *(const float4*)(src + i * 4); f[i * 4] = v.x; f[i * 4 + 1] = v.y; f[i * 4 + 2] = v.z; f[i * 4 + 3] = v.w; }
      *(bf16x8*)dst = pack8(f); *(bf16x8*)(dst + 8) = pack8(f + 8);
    } else {
      const int r0 = (id - 4448) * 16;
      const float* xr0 = r0 < TCTX ? p->x_prompt + (size_t)r0 * 1024 : p->x_sample + (size_t)(r0 - TCTX) * 1024;
      const float* mod = (const float*)(p->ws + OFF_MOD) + (size_t)cv_of(r0) * 6144;
      u16* H = (u16*)(p->ws + OFF_H) + (size_t)r0 * 1024;
#pragma unroll 2
      for (int i = 0; i < 8; ++i) {
        const int c = tidc + i * 256, row = c >> 7, kc = (c & 127) * 8;
        AModX al{xr0, mod + 1024, mod};
        *(bf16x8*)(H + (size_t)row * 1024 + kc) = al(row, kc);
      }
    }
  }
}

DEV int vblock() { const int G = gridDim.x, b = blockIdx.x; return (G & 7) == 0 ? (b & 7) * (G >> 3) + (b >> 3) : b; }
DEV void tile_map(int id, int NT, int& mt, int& nt) { const int g = id / (8 * NT), r = id - g * 8 * NT; nt = r >> 3; mt = g * 8 + (r & 7); }

constexpr size_t OFF_GQ = 491520;
struct TQ { unsigned* q; int nt; int xcc; int tries; };
DEV int xcc_id() { return (int)(__builtin_amdgcn_s_getreg((3 << 11) | 20) & 7u); }
DEV int tq_pull(TQ& t, int* slot, int tid) {
  __syncthreads();
  if (tid == 0) {
    int id = -1;
    while (t.tries < 8) {
      const int x = (t.xcc + t.tries) & 7;
      const int start = (t.nt * x) >> 3, end = (t.nt * (x + 1)) >> 3;
      const int k = (int)atomicAdd(t.q + x * 16, 1u);
      if (start + k < end) { id = start + k; break; }
      ++t.tries;
    }
    *slot = id;
  }
  __syncthreads();
  return *slot;
}

DEV void inproj_qk_epilogue(PPtr p, int l, f32x4 (&acc)[4][4], u16* Ct, int m0, int nt) {
  __syncthreads();
  epi_foreach<4>(acc, [&](int r, int c, float v) { Ct[r * 136 + c] = f2bf(v); });
  __syncthreads();
  const int tid = tid_(), s = tid & 7;
  const bool isk = nt == 12;
  u16* Qf = (u16*)(p->ws + OFF_P) + F_Q;
  u16* KC = (u16*)(p->ws + OFF_KC);
  const float* g = (isk ? p->k_norm : p->q_norm) + l * 64 + s * 8;
#pragma unroll 1
  for (int it = 0; it < 8; ++it) {
    const int slot = it * 256 + tid, pair = slot >> 3, row = pair >> 1, hd = pair & 1;
    const int t = m0 + row;
    const bool lat = t >= TCTX;
    const int b = lat ? (t - TCTX) >> 11 : t >> 8;
    const int pos = lat ? (t - TCTX) & 2047 : t & 255;
    float f[8]; unpack8(*(const bf16x8*)(Ct + row * 136 + hd * 64 + s * 8), f);
    float ss = 0.f;
#pragma unroll
    for (int i = 0; i < 8; ++i) ss += f[i] * f[i];
    ss += dpp_xor1(ss); ss += dpp_xor2(ss); ss += dpp_hmirror(ss);
    const float rs = rsqrtf(ss * (1.f / 64.f) + 1e-6f);
#pragma unroll
    for (int i = 0; i < 8; ++i) f[i] = f[i] * rs * g[i];
    if (lat) {
      const float posv = (float)((s < 4) ? (pos >> 6) : (pos & 63));
#pragma unroll
      for (int i = 0; i < 8; ++i) {
        const float fi = (float)((s & 1) * 8 + i);
        const float ang = posv * exp2f(-fi * (13.287712379549449f / 16.f));
        const float cs = __cosf(ang), sn = __sinf(ang);
        const float pf = dpp_xor2(f[i]);
        f[i] = (s & 2) ? (f[i] * cs + pf * sn) : (f[i] * cs - pf * sn);
      }
    }
    const bf16x8 o = pack8(f);
    if (!isk) *(bf16x8*)(Qf + (size_t)t * 512 + (nt - 8) * 128 + hd * 64 + s * 8) = o;
    else if (lat) *(bf16x8*)(KC + KC_LAT + ((size_t)(b * 2 + hd) * 2560 + 512 + pos) * 64 + s * 8) = o;
    else {
      *(bf16x8*)(KC + ((size_t)(b * 2 + hd) * 256 + pos) * 64 + s * 8) = o;
      float* d = p->out + O_NCK + ((((size_t)b * 2 + l) * 256 + pos) * 2 + hd) * 64 + s * 8;
      *(float4*)d = make_float4(f[0], f[1], f[2], f[3]);
      *(float4*)(d + 4) = make_float4(f[4], f[5], f[6], f[7]);
    }
  }
}
DEV void inproj_v_epilogue(PPtr p, int l, f32x4 (&acc)[4][4], u16* Ct, int m0) {
  __syncthreads();
  epi_foreach<4>(acc, [&](int r, int c, float v) { Ct[r * 136 + c] = f2bf(v); });
  __syncthreads();
  const int tid = tid_();
  u16* VT = (u16*)(p->ws + OFF_VT);
  const bool lat = m0 >= TCTX;
  const int b = lat ? (m0 - TCTX) >> 11 : m0 >> 8;
  const int pos0 = lat ? (m0 - TCTX) & 2047 : m0 & 255;
  if (!lat) {
#pragma unroll 2
    for (int i = 0; i < 8; ++i) {
      const int c = tid + i * 256, row = c >> 4, cc = (c & 15) * 8;
      float f[8]; unpack8(*(const bf16x8*)(Ct + row * 136 + cc), f);
      float* d = p->out + O_NCV + ((((size_t)b * 2 + l) * 256 + pos0 + row) * 2 + (cc >> 6)) * 64 + (cc & 63);
      *(float4*)d = make_float4(f[0], f[1], f[2], f[3]);
      *(float4*)(d + 4) = make_float4(f[4], f[5], f[6], f[7]);
    }
  }
#pragma unroll 2
  for (int i = 0; i < 8; ++i) {
    const int c = tid + i * 256, kvh = c >> 10, d = (c >> 4) & 63, kc = c & 15;
    bf16x8 o;
#pragma unroll
    for (int e = 0; e < 8; ++e) o[e] = (short)Ct[(kc * 8 + e) * 136 + kvh * 64 + d];
    u16* dst = lat ? VT + KC_LAT + ((size_t)(b * 2 + kvh) * 64 + d) * 2560 + 512 + pos0 + kc * 8
                   : VT + ((size_t)(b * 2 + kvh) * 64 + d) * 256 + pos0 + kc * 8;
    *(bf16x8*)dst = o;
  }
}
DEV void cache_tile(PPtr p, int l, int u, unsigned char* smem) {
  u16* KC = (u16*)(p->ws + OFF_KC);
  u16* VT = (u16*)(p->ws + OFF_VT);
  const int tid = tid_();
  const int b = u >> 4, kvh = (u >> 3) & 1, kb = u & 7;
  u16* tile = (u16*)smem;
  const int key = tid >> 2, dc = (tid & 3) * 16;
  float f[16], fk[16];
  __syncthreads();
  const int pk = kb * 64 + key;
  const float* sv = p->cache_v + (((size_t)(b * 2 + l) * 512 + pk) * 2 + kvh) * 64 + dc;
  const float* sk = p->cache_k + (((size_t)(b * 2 + l) * 512 + pk) * 2 + kvh) * 64 + dc;
#pragma unroll
  for (int i = 0; i < 4; ++i) {
    float4 v = *(const float4*)(sv + i * 4); f[i * 4] = v.x; f[i * 4 + 1] = v.y; f[i * 4 + 2] = v.z; f[i * 4 + 3] = v.w;
    float4 k = *(const float4*)(sk + i * 4); fk[i * 4] = k.x; fk[i * 4 + 1] = k.y; fk[i * 4 + 2] = k.z; fk[i * 4 + 3] = k.w;
  }
  u16* kd = KC + KC_LAT + ((size_t)(b * 2 + kvh) * 2560 + pk) * 64 + dc;
  *(bf16x8*)kd = pack8(fk); *(bf16x8*)(kd + 8) = pack8(fk + 8);
#pragma unroll
  for (int i = 0; i < 16; ++i) tile[(dc + i) * 72 + key] = f2bf(f[i]);
  __syncthreads();
  const int d = tid >> 2, kc = (tid & 3) * 16;
  bf16x8 o0 = *(const bf16x8*)(tile + d * 72 + kc), o1 = *(const bf16x8*)(tile + d * 72 + kc + 8);
  u16* dst = VT + KC_LAT + ((size_t)(b * 2 + kvh) * 64 + d) * 2560 + kb * 64 + kc;
  *(bf16x8*)dst = o0; *(bf16x8*)(dst + 8) = o1;
}

DEV void phase_inproj(PPtr p, int l, unsigned char* smem) {
  u16* Ct = (u16*)(smem + 32768);
  const u16* W = (const u16*)(p->ws + OFF_W);
  const u16* H = (const u16*)(p->ws + OFF_H);
  u16* P = (u16*)(p->ws + OFF_P);
  TQ tq{(unsigned*)(p->ws + OFF_GQ) + (l * 5 + 0) * 128, 192 * 29, xcc_id(), 0};
  int* slot = (int*)(smem + SMEM_BYTES - 16);
  const int tidq = tid_();
  bool pre = false;
  int id = tq_pull(tq, slot, tidq);
  while (id >= 0) {
    int mt, nt; tile_map(id, 29, mt, nt);
    const int m0 = mt * 128, n0 = nt * 128;
    const int idn = tq_pull(tq, slot, tidq); const bool hn = idn >= 0;
    int mtn = 0, ntn = 0; if (hn) tile_map(idn, 29, mtn, ntn);
    f32x4 acc[4][4]; zero_acc<4>(acc);
    gemm_mainloop_dma<4>(acc, H + (size_t)m0 * 1024, 1024, W + W_IN + (size_t)n0 * 1024, 1024, 1024, smem, pre,
                         hn ? H + (size_t)mtn * 128 * 1024 : nullptr, 1024, W + W_IN + (size_t)ntn * 128 * 1024, 1024);
    pre = hn;
    if (nt >= 8 && nt <= 12) { inproj_qk_epilogue(p, l, acc, Ct, m0, nt); id = idn; continue; }
    if (nt == 13) { inproj_v_epilogue(p, l, acc, Ct, m0); id = idn; continue; }
    u16* dst; int ld;
    if (n0 < 512) { dst = P + F_UA + n0; ld = 512; }
    else if (n0 < 1024) { dst = P + F_VA + (n0 - 512); ld = 512; }
    else if (n0 < 1536) { dst = P + F_Q + (n0 - 1024); ld = 512; }
    else if (n0 < 1664) { dst = P + F_KK; ld = 128; }
    else if (n0 < 1792) { dst = P + F_VV; ld = 128; }
    else if (n0 < 3328) { dst = P + F_RKV + (n0 - 1792); ld = 1536; }
    else if (n0 < 3584) { dst = P + F_LORA + (n0 - 3328); ld = 256; }
    else { dst = P + F_GD; ld = 128; }
    dst += (size_t)m0 * ld;
    epi_bf16<4>(acc, Ct, dst, ld, [](int, int, float v) { return v; });
    id = idn;
  }
  for (int u = blockIdx.x; u < 128; u += gridDim.x) cache_tile(p, l, u, smem);
}


DEV void attn_item(PPtr p, int item, bool lat, unsigned char* smem) {
  u16* Ks = (u16*)smem; u16* Vs = Ks + 64 * 72;
  u16* P = (u16*)(p->ws + OFF_P);
  const int tid = tid_(), lane = tid & 63, wave = tid >> 6, l15 = lane & 15, quad = lane >> 4;
  int b, kvh, qb, LK; size_t tq0; const u16 *Kc, *VTc;
  if (lat) {
    b = item >> 7; kvh = (item >> 6) & 1; qb = item & 63; LK = 2560;
    tq0 = TCTX + (size_t)b * 2048 + qb * 32;
    Kc = (const u16*)(p->ws + OFF_KC) + KC_LAT + (size_t)(b * 2 + kvh) * 2560 * 64;
    VTc = (const u16*)(p->ws + OFF_VT) + KC_LAT + (size_t)(b * 2 + kvh) * 64 * 2560;
  } else {
    b = item >> 4; kvh = (item >> 3) & 1; qb = item & 7; LK = 256;
    tq0 = (size_t)b * 256 + qb * 32;
    Kc = (const u16*)(p->ws + OFF_KC) + (size_t)(b * 2 + kvh) * 256 * 64;
    VTc = (const u16*)(p->ws + OFF_VT) + (size_t)(b * 2 + kvh) * 64 * 256;
  }
  const int hq = kvh * 4 + wave;
  bf16x8 qf[2][2];
#pragma unroll
  for (int qt = 0; qt < 2; ++qt)
#pragma unroll
    for (int ks = 0; ks < 2; ++ks) qf[qt][ks] = *(const bf16x8*)(P + F_Q + (tq0 + qt * 16 + l15) * 512 + hq * 64 + ks * 32 + quad * 8);
  f32x4 o[4][2];
#pragma unroll
  for (int dt = 0; dt < 4; ++dt)
#pragma unroll
    for (int qt = 0; qt < 2; ++qt) o[dt][qt] = (f32x4){0.f, 0.f, 0.f, 0.f};
  float mrow[2] = {-1e30f, -1e30f}, lrow[2] = {0.f, 0.f};
  const float C = 0.125f * 1.4426950408889634f;
  bf16x8 rk[2], rv[2];
#pragma unroll
  for (int i = 0; i < 2; ++i) {
    int c = tid + i * 256, r = c >> 3, cc = (c & 7) * 8;
    rk[i] = *(const bf16x8*)(Kc + (size_t)r * 64 + cc);
    rv[i] = *(const bf16x8*)(VTc + (size_t)r * LK + cc);
  }
  const int nt = LK >> 6;
  for (int kt = 0; kt < nt; ++kt) {
    __syncthreads();
#pragma unroll
    for (int i = 0; i < 2; ++i) {
      int c = tid + i * 256, r = c >> 3, cc = (c & 7) * 8;
      *(bf16x8*)(Ks + r * 72 + cc) = rk[i];
      *(bf16x8*)(Vs + r * 72 + cc) = rv[i];
    }
    __syncthreads();
    if (kt + 1 < nt) {
      const int key0 = (kt + 1) * 64;
#pragma unroll
      for (int i = 0; i < 2; ++i) {
        int c = tid + i * 256, r = c >> 3, cc = (c & 7) * 8;
        rk[i] = *(const bf16x8*)(Kc + (size_t)(key0 + r) * 64 + cc);
        rv[i] = *(const bf16x8*)(VTc + (size_t)r * LK + key0 + cc);
      }
    }
    f32x4 s[4][2];
#pragma unroll
    for (int nk = 0; nk < 4; ++nk)
#pragma unroll
      for (int qt = 0; qt < 2; ++qt) s[nk][qt] = (f32x4){0.f, 0.f, 0.f, 0.f};
#pragma unroll
    for (int ks = 0; ks < 2; ++ks)
#pragma unroll
      for (int nk = 0; nk < 4; ++nk) {
        bf16x8 a = *(const bf16x8*)(Ks + (nk * 16 + l15) * 72 + ks * 32 + quad * 8);
#pragma unroll
        for (int qt = 0; qt < 2; ++qt) s[nk][qt] = mfma16(a, qf[qt][ks], s[nk][qt]);
      }
#pragma unroll
    for (int qt = 0; qt < 2; ++qt) {
      float mx = -1e30f;
#pragma unroll
      for (int nk = 0; nk < 4; ++nk)
#pragma unroll
        for (int j = 0; j < 4; ++j) mx = fmaxf(mx, s[nk][qt][j]);
      mx = fmaxf(mx, shx(mx, 16, lane)); mx = fmaxf(mx, shx(mx, 32, lane));
      const float mnew = fmaxf(mrow[qt], mx);
      const float alpha = __builtin_amdgcn_exp2f((mrow[qt] - mnew) * C);
      mrow[qt] = mnew;
      lrow[qt] *= alpha;
#pragma unroll
      for (int dt = 0; dt < 4; ++dt) { o[dt][qt][0] *= alpha; o[dt][qt][1] *= alpha; o[dt][qt][2] *= alpha; o[dt][qt][3] *= alpha; }
      const float nmc = -mrow[qt] * C;
      float ls = 0.f;
#pragma unroll
      for (int nk = 0; nk < 4; ++nk)
#pragma unroll
        for (int j = 0; j < 4; ++j) { float pv = __builtin_amdgcn_exp2f(__builtin_fmaf(s[nk][qt][j], C, nmc)); ls += pv; s[nk][qt][j] = pv; }
      lrow[qt] += ls;
    }
#pragma unroll
    for (int ks = 0; ks < 2; ++ks) {
      bf16x8 pf[2];
#pragma unroll
      for (int qt = 0; qt < 2; ++qt) {
#pragma unroll
        for (int j = 0; j < 4; ++j) { pf[qt][j] = (short)f2bf(s[2 * ks][qt][j]); pf[qt][4 + j] = (short)f2bf(s[2 * ks + 1][qt][j]); }
      }
#pragma unroll
      for (int dt = 0; dt < 4; ++dt) {
        const u16* vr = Vs + (dt * 16 + l15) * 72 + quad * 4;
        bf16x4 v0 = *(const bf16x4*)(vr + (2 * ks) * 16), v1 = *(const bf16x4*)(vr + (2 * ks + 1) * 16);
        bf16x8 a;
        a[0] = v0[0]; a[1] = v0[1]; a[2] = v0[2]; a[3] = v0[3]; a[4] = v1[0]; a[5] = v1[1]; a[6] = v1[2]; a[7] = v1[3];
#pragma unroll
        for (int qt = 0; qt < 2; ++qt) o[dt][qt] = mfma16(a, pf[qt], o[dt][qt]);
      }
    }
  }
#pragma unroll
  for (int qt = 0; qt < 2; ++qt) {
    float lsum = lrow[qt];
    lsum += shx(lsum, 16, lane); lsum += shx(lsum, 32, lane);
    const float inv = frcp(lsum);
#pragma unroll
    for (int dt = 0; dt < 4; ++dt) {
      bf16x4 ov;
#pragma unroll
      for (int j = 0; j < 4; ++j) ov[j] = (short)f2bf(o[dt][qt][j] * inv);
      *(bf16x4*)(P + F_Q + (tq0 + qt * 16 + l15) * 512 + hq * 64 + dt * 16 + quad * 4) = ov;
    }
  }
}

DEV void sgu_item(PPtr p, int l, int item, unsigned char* smem) {
  u16* VnT = (u16*)smem;
  float* stats = (float*)(smem + 128 * 136 * 2);
  u16* P = (u16*)(p->ws + OFF_P);
  const u16* Wsb = (const u16*)(p->ws + OFF_W) + W_SGU;
  const int tid = tid_(), lane = tid & 63, wave = tid >> 6, l15 = lane & 15, quad = lane >> 4;
  const int wr = wave >> 1, wc = wave & 1;
  const size_t t0 = (size_t)item * 128;
  __syncthreads();
  {
    const int tok = tid >> 1, half = tid & 1;
    const u16* vr = P + F_VA + (t0 + tok) * 512 + half * 256;
    float sum = 0.f, sq = 0.f;
    for (int i = 0; i < 32; ++i) {
      float f[8]; unpack8(*(const bf16x8*)(vr + i * 8), f);
#pragma unroll
      for (int e = 0; e < 8; ++e) { sum += f[e]; sq += f[e] * f[e]; }
    }
    sum += dpp_xor1(sum); sq += dpp_xor1(sq);
    const float mu = sum * (1.f / 512.f);
    const float var = fmaxf(sq * (1.f / 512.f) - mu * mu, 0.f);
    if (half == 0) { stats[tok * 2] = mu; stats[tok * 2 + 1] = rsqrtf(var + 1e-5f); }
  }
  __syncthreads();
  for (int g = 0; g < 4; ++g) {
    {
      const int q = tid & 127, hf = tid >> 7;
      const float mu = stats[q * 2], rs = stats[q * 2 + 1];
      const u16* vr = P + F_VA + (t0 + q) * 512 + g * 128 + hf * 64;
      const float* lg = p->sgu_ln_g + l * 512 + g * 128 + hf * 64;
      const float* lb = p->sgu_ln_b + l * 512 + g * 128 + hf * 64;
      for (int i = 0; i < 8; ++i) {
        float f[8]; unpack8(*(const bf16x8*)(vr + i * 8), f);
#pragma unroll
        for (int e = 0; e < 8; ++e) VnT[(hf * 64 + i * 8 + e) * 136 + q] = f2bf((f[e] - mu) * rs * lg[i * 8 + e] + lb[i * 8 + e]);
      }
    }
    __syncthreads();
    f32x4 acc[4][4]; zero_acc<4>(acc);
#pragma unroll
    for (int ks = 0; ks < 4; ++ks) {
      bf16x8 a[4], bb[4];
#pragma unroll
      for (int m = 0; m < 4; ++m) a[m] = *(const bf16x8*)(Wsb + (size_t)g * 16384 + (wr * 64 + m * 16 + l15) * 128 + ks * 32 + quad * 8);
#pragma unroll
      for (int n = 0; n < 4; ++n) bb[n] = *(const bf16x8*)(VnT + (wc * 64 + n * 16 + l15) * 136 + ks * 32 + quad * 8);
#pragma unroll
      for (int m = 0; m < 4; ++m)
#pragma unroll
        for (int n = 0; n < 4; ++n) acc[m][n] = mfma16(a[m], bb[n], acc[m][n]);
    }
    const float* bias = p->sgu_b + l * 512 + g * 128;
    u16* ua = P + F_UA + t0 * 512 + g * 128;
    {
      u16* Cs = (u16*)(smem + 128 * 136 * 2 + 1024);
      epi_foreach<4>(acc, [&](int r, int c, float v) { Cs[r * 136 + c] = f2bf(v + bias[r]); });
      __syncthreads();
#pragma unroll 2
      for (int i = 0; i < 8; ++i) {
        const int c = tid + i * 256, row = c >> 4, cc = (c & 15) * 8;
        u16* e = ua + (size_t)row * 512 + cc;
        float fu[8], fs[8];
        unpack8(*(const bf16x8*)e, fu); unpack8(*(const bf16x8*)(Cs + row * 136 + cc), fs);
#pragma unroll
        for (int k = 0; k < 8; ++k) fu[k] *= fs[k];
        *(bf16x8*)e = pack8(fu);
      }
    }
    __syncthreads();
  }
}

template <int RS>
DEV void scan_item(PPtr p, int l, int item, bool lat, unsigned char* smem) {
  float* sR = (float*)smem;
  float* sK = sR + 2048; float* sV = sK + 2048; float* sW = sV + 2048; float* sA = sW + 2048; float* sB = sA + 2048;
  float* sY = sB + 2048;
  u16* XW = (u16*)(sY + 2048);
  u16* XA = XW + 32 * 72;
  const u16* P = (const u16*)(p->ws + OFF_P);
  const u16* Wb = (const u16*)(p->ws + OFF_W);
  u16* Y = (u16*)(p->ws + OFF_Y);
  float* COEF = (float*)(p->ws + OFF_COEF);
  const int tid = tid_(), lane = tid & 63, wave = tid >> 6, l15 = lane & 15, quad = lane >> 4;
  constexpr int LPR = 4 * RS, KPL = 16 / RS, ROWS = 64 / RS, NV4 = KPL / 4, KP2 = KPL / 2;
  if (lat) __builtin_amdgcn_s_setprio(3);
  const int rpart = item % RS, sci = item / RS;
  const int b = sci >> 4, h = (sci >> 1) & 7, d = sci & 1;
  const int L = lat ? 2048 : 256;
  const size_t tbase = lat ? TCTX + (size_t)b * 2048 : (size_t)b * 256;
  const int v = rpart * ROWS + tid / LPR, kq = tid % LPR, key0 = kq * KPL;
  f32x2 S2[KP2];
  if (lat) {
    const float* s0 = p->state_wkv + ((((size_t)(b * 2 + l) * 2 + d) * 8 + h) * 64 + v) * 64 + key0;
#pragma unroll
    for (int i = 0; i < NV4; ++i) { float4 t4 = *(const float4*)(s0 + i * 4); S2[2 * i] = (f32x2){t4.x, t4.y}; S2[2 * i + 1] = (f32x2){t4.z, t4.w}; }
  } else {
#pragma unroll
    for (int i = 0; i < KP2; ++i) S2[i] = (f32x2){0.f, 0.f};
  }
  const float* mu = p->rwkv_mu + (size_t)(l * 2 + d) * 1664;
  const int sl = tid >> 3, part = tid & 7, ch0 = part * 8;
  float* sC = (float*)(XA + 32 * 72);
  __syncthreads();
  if (tid < 64) {
    sC[tid] = mu[h * 64 + tid]; sC[64 + tid] = mu[512 + h * 64 + tid]; sC[128 + tid] = mu[1024 + h * 64 + tid];
    sC[192 + tid] = mu[1536 + tid]; sC[256 + tid] = mu[1600 + tid];
    sC[320 + tid] = p->rwkv_k_k[l * 512 + h * 64 + tid]; sC[384 + tid] = p->rwkv_k_a[l * 512 + h * 64 + tid]; sC[448 + tid] = p->rwkv_r_k[l * 512 + h * 64 + tid];
  }
  __syncthreads();
  const int lm = wave & 1, ln0 = (wave >> 1) * 2;
  const u16* w2T = Wb + W_W2 + (size_t)d * 512 * 64 + (size_t)(h * 64) * 64;
  const u16* a2T = Wb + W_A2 + (size_t)d * 512 * 64 + (size_t)(h * 64) * 64;
  const float* w0 = p->rwkv_w0 + (size_t)(l * 2 + d) * 512 + h * 64;
  const float* a0 = p->rwkv_a0 + (size_t)(l * 2 + d) * 512 + h * 64;
  const int nch = L >> 5;
  bf16x8 q_r, q_k, q_v, q_w, q_a, n_r, n_k, n_v, n_w, n_a;
#define SCAN_FETCH(cc)                                                                                   \
  {                                                                                                      \
    const int s_ = (cc) * 32 + sl;                                                                       \
    const size_t t_ = tbase + (d ? (L - 1 - s_) : s_);                                                   \
    const size_t tn_ = (s_ > 0) ? (d ? t_ + 1 : t_ - 1) : t_;                                            \
    q_r = *(const bf16x8*)(P + F_RKV + t_ * 1536 + h * 64 + ch0);                                        \
    q_k = *(const bf16x8*)(P + F_RKV + t_ * 1536 + 512 + h * 64 + ch0);                                  \
    q_v = *(const bf16x8*)(P + F_RKV + t_ * 1536 + 1024 + h * 64 + ch0);                                 \
    q_w = *(const bf16x8*)(P + F_LORA + t_ * 256 + d * 128 + ch0);                                       \
    q_a = *(const bf16x8*)(P + F_LORA + t_ * 256 + d * 128 + 64 + ch0);                                  \
    n_r = *(const bf16x8*)(P + F_RKV + tn_ * 1536 + h * 64 + ch0);                                       \
    n_k = *(const bf16x8*)(P + F_RKV + tn_ * 1536 + 512 + h * 64 + ch0);                                 \
    n_v = *(const bf16x8*)(P + F_RKV + tn_ * 1536 + 1024 + h * 64 + ch0);                                \
    n_w = *(const bf16x8*)(P + F_LORA + tn_ * 256 + d * 128 + ch0);                                      \
    n_a = *(const bf16x8*)(P + F_LORA + tn_ * 256 + d * 128 + 64 + ch0);                                 \
  }
  SCAN_FETCH(0)
  bf16x8 bwf[2][2], baf[2][2];
#pragma unroll
  for (int ks = 0; ks < 2; ++ks)
#pragma unroll
    for (int n = 0; n < 2; ++n) {
      bwf[ks][n] = *(const bf16x8*)(w2T + (size_t)((ln0 + n) * 16 + l15) * 64 + ks * 32 + quad * 8);
      baf[ks][n] = *(const bf16x8*)(a2T + (size_t)((ln0 + n) * 16 + l15) * 64 + ks * 32 + quad * 8);
    }
  for (int c = 0; c < nch; ++c) {
    const int s = c * 32 + sl;
    const int pos = d ? (L - 1 - s) : s;
    const size_t t = tbase + pos;
    const bool hasnb = s > 0;
    float fr[8], fk[8], fv[8], fw[8], fa[8];
    {
      unpack8(q_r, fr); unpack8(q_k, fk); unpack8(q_v, fv); unpack8(q_w, fw); unpack8(q_a, fa);
      float nr[8], nk[8], nv[8], nw[8], na[8];
      unpack8(n_r, nr); unpack8(n_k, nk); unpack8(n_v, nv); unpack8(n_w, nw); unpack8(n_a, na);
      if (!hasnb) {
#pragma unroll
        for (int i = 0; i < 8; ++i) { nr[i] = 0.f; nk[i] = 0.f; nv[i] = 0.f; nw[i] = 0.f; na[i] = 0.f; }
      }
#pragma unroll
      for (int i = 0; i < 8; ++i) {
        fr[i] += sC[ch0 + i] * (nr[i] - fr[i]); fk[i] += sC[64 + ch0 + i] * (nk[i] - fk[i]); fv[i] += sC[128 + ch0 + i] * (nv[i] - fv[i]);
        fw[i] += sC[192 + ch0 + i] * (nw[i] - fw[i]); fa[i] += sC[256 + ch0 + i] * (na[i] - fa[i]);
      }
    }
    if (c + 1 < nch) SCAN_FETCH(c + 1)
    {
      float tw[8];
#pragma unroll
      for (int i = 0; i < 8; ++i) tw[i] = 1.f - 2.f * frcp(__expf(2.f * fw[i]) + 1.f);
      *(bf16x8*)(XW + sl * 72 + ch0) = pack8(tw);
      *(bf16x8*)(XA + sl * 72 + ch0) = pack8(fa);
#pragma unroll
      for (int i = 0; i < 8; ++i) { sR[sl * 64 + ch0 + i] = fr[i]; sV[sl * 64 + ch0 + i] = fv[i]; }
    }
    __syncthreads();
    {
      f32x4 aw[2], aa[2];
#pragma unroll
      for (int n = 0; n < 2; ++n) { aw[n] = (f32x4){0.f, 0.f, 0.f, 0.f}; aa[n] = (f32x4){0.f, 0.f, 0.f, 0.f}; }
#pragma unroll
      for (int ks = 0; ks < 2; ++ks) {
        bf16x8 xw = *(const bf16x8*)(XW + (lm * 16 + l15) * 72 + ks * 32 + quad * 8);
        bf16x8 xa = *(const bf16x8*)(XA + (lm * 16 + l15) * 72 + ks * 32 + quad * 8);
#pragma unroll
        for (int n = 0; n < 2; ++n) {
          aw[n] = mfma16(xw, bwf[ks][n], aw[n]);
          aa[n] = mfma16(xa, baf[ks][n], aa[n]);
        }
      }
#pragma unroll
      for (int n = 0; n < 2; ++n) {
        const int ch = (ln0 + n) * 16 + l15;
        const float w0c = w0[ch], a0c = a0[ch];
#pragma unroll
        for (int j = 0; j < 4; ++j) {
          const int row = lm * 16 + quad * 4 + j;
          const float z = w0c + aw[n][j];
          sW[row * 64 + ch] = __expf(-0.60653065971263342f * sigmoidf_(z));
          sA[row * 64 + ch] = sigmoidf_(a0c + aa[n][j]);
        }
      }
    }
    __syncthreads();
    {
      float av[8], kk[8], ssq = 0.f, cf = 0.f;
#pragma unroll
      for (int i = 0; i < 8; ++i) { av[i] = sA[sl * 64 + ch0 + i]; kk[i] = fk[i] * sC[320 + ch0 + i]; ssq += kk[i] * kk[i]; }
      ssq += dpp_xor1(ssq); ssq += dpp_xor2(ssq); ssq += dpp_hmirror(ssq);
      const float inv = rsqrtf(fmaxf(ssq, 1e-24f));
#pragma unroll
      for (int i = 0; i < 8; ++i) {
        const float kn = kk[i] * inv;
        const float km = fk[i] * (1.f + (av[i] - 1.f) * sC[384 + ch0 + i]);
        cf += fr[i] * km * sC[448 + ch0 + i];
        sK[sl * 64 + ch0 + i] = km;
        sA[sl * 64 + ch0 + i] = -kn;
        sB[sl * 64 + ch0 + i] = kn * av[i];
      }
      cf += dpp_xor1(cf); cf += dpp_xor2(cf); cf += dpp_hmirror(cf);
      if (part == 0 && rpart == 0) COEF[(t * 8 + h) * 2 + d] = cf;
    }
    __syncthreads();
    {
      f32x2 wA[KP2], kA[KP2], aA[KP2], bA[KP2], rA[KP2]; float vA;
#define SCAN_LD(X_, arr_, st_)                                                                                   \
  _Pragma("unroll") for (int i = 0; i < NV4; ++i) {                                                              \
    const float4 t4 = *(const float4*)((arr_) + (st_) * 64 + key0 + i * 4);                                      \
    X_[2 * i] = (f32x2){t4.x, t4.y}; X_[2 * i + 1] = (f32x2){t4.z, t4.w};                                        \
  }
      SCAN_LD(aA, sA, 0) SCAN_LD(kA, sK, 0) SCAN_LD(bA, sB, 0) SCAN_LD(wA, sW, 0) SCAN_LD(rA, sR, 0)
      vA = sV[v];
      constexpr bool DEFER = (RS >= 2);
      float yp[DEFER ? 32 : 1];
#pragma unroll(DEFER ? 32 : 2)
      for (int st = 0; st < 32; ++st) {
        const int sn = (st + 1) & 31;
        f32x2 sacc = S2[0] * aA[0];
#pragma unroll
        for (int i = 1; i < KP2; ++i) sacc = __builtin_elementwise_fma(S2[i], aA[i], sacc);
        SCAN_LD(aA, sA, sn)
        const f32x2 vv = {vA, vA};
        f32x2 vk[KP2];
#pragma unroll
        for (int i = 0; i < KP2; ++i) vk[i] = vv * kA[i];
        SCAN_LD(kA, sK, sn)
        vA = sV[sn * 64 + v];
        float sa = sacc.x + sacc.y;
        sa += dpp_xor1(sa); sa += dpp_xor2(sa);
        if (LPR >= 8) sa += dpp_hmirror(sa);
        if (LPR >= 16) sa += dpp_mirror(sa);
        const f32x2 sav = {sa, sa};
#pragma unroll
        for (int i = 0; i < KP2; ++i) vk[i] = __builtin_elementwise_fma(sav, bA[i], vk[i]);
        SCAN_LD(bA, sB, sn)
#pragma unroll
        for (int i = 0; i < KP2; ++i) S2[i] = __builtin_elementwise_fma(S2[i], wA[i], vk[i]);
        SCAN_LD(wA, sW, sn)
        f32x2 yacc = S2[0] * rA[0];
#pragma unroll
        for (int i = 1; i < KP2; ++i) yacc = __builtin_elementwise_fma(S2[i], rA[i], yacc);
        SCAN_LD(rA, sR, sn)
        if (DEFER) yp[DEFER ? st : 0] = yacc.x + yacc.y;
        else {
          float y = yacc.x + yacc.y;
          y += dpp_xor1(y); y += dpp_xor2(y);
          if (LPR >= 8) y += dpp_hmirror(y);
          if (LPR >= 16) y += dpp_mirror(y);
          sY[st * 64 + v] = y;
        }
      }
      if (DEFER) {
#pragma unroll
      for (int st = 0; st < 32; ++st) yp[st] += dpp_xor1(yp[st]);
#pragma unroll
      for (int st = 0; st < 32; ++st) yp[st] += dpp_xor2(yp[st]);
      if (LPR >= 8) {
#pragma unroll
        for (int st = 0; st < 32; ++st) yp[st] += dpp_hmirror(yp[st]);
      }
      if (LPR >= 16) {
#pragma unroll
        for (int st = 0; st < 32; ++st) yp[st] += dpp_mirror(yp[st]);
      }
#pragma unroll
      for (int st = 0; st < 32; ++st) sY[st * 64 + v] = yp[st];
      }
#undef SCAN_LD
    }
    __syncthreads();
    {
      float yv[8];
#pragma unroll
      for (int i = 0; i < 8; ++i) yv[i] = sY[sl * 64 + ch0 + i];
      if (ch0 >= rpart * ROWS && ch0 < (rpart + 1) * ROWS) *(bf16x8*)(Y + (size_t)d * TT * 512 + t * 512 + h * 64 + ch0) = pack8(yv);
    }
#undef SCAN_FETCH_DUMMY
  }
  __builtin_amdgcn_s_setprio(0);
  if (!lat) {
    float* dst = p->out + O_NST + ((((size_t)(b * 2 + l) * 2 + d) * 8 + h) * 64 + v) * 64 + key0;
#pragma unroll
    for (int i = 0; i < NV4; ++i) *(float4*)(dst + i * 4) = make_float4(S2[2 * i].x, S2[2 * i].y, S2[2 * i + 1].x, S2[2 * i + 1].y);
  }
  __syncthreads();
}

constexpr int SCAN_RS = 2;
constexpr int SCAN_RS_CTX = 1;
constexpr int MIX_LS = 128 * SCAN_RS, MIX_CS = 512 * SCAN_RS_CTX, MIX_LA = 1024, MIX_SG = 192, MIX_CA = 512;
constexpr int MIX_B = MIX_LA + MIX_CS + MIX_SG + MIX_CA;
constexpr size_t OFF_CUTAB = 458752;

DEV void phase_mix(PPtr p, int l, unsigned char* smem) {
  unsigned* ctrA = (unsigned*)(p->ws + OFF_CTR) + l * 2;
  unsigned* ctrB = ctrA + 1;
  int* slot = (int*)(smem + SMEM_BYTES - 16);
  const int tidm = tid_();
  __syncthreads();
  if (tidm == 0) {
    const unsigned hw = __builtin_amdgcn_s_getreg((31 << 11) | 4), xcc = __builtin_amdgcn_s_getreg((3 << 11) | 20);
    const unsigned key = ((xcc & 15u) << 8) | ((hw >> 8) & 255u);
    slot[1] = (int)atomicAdd((unsigned*)(p->ws + OFF_CUTAB) + l * 4096 + key, 1u);
  }
  __syncthreads();
  const bool primary = slot[1] == 0;
  bool a_open = true, b_open = true;
  for (;;) {
    __syncthreads();
    if (tidm == 0) {
      int it = -1;
      if (primary) {
        if (a_open) { it = (int)atomicAdd(ctrA, 1u); if (it >= MIX_LS) { a_open = false; it = -1; } }
        if (it < 0 && b_open) { it = (int)atomicAdd(ctrB, 1u); if (it >= MIX_B) { b_open = false; it = -1; } else it += MIX_LS; }
      } else {
        if (b_open) { it = (int)atomicAdd(ctrB, 1u); if (it >= MIX_B) { b_open = false; it = -1; } else it += MIX_LS; }
        if (it < 0 && a_open) { it = (int)atomicAdd(ctrA, 1u); if (it >= MIX_LS) { a_open = false; it = -1; } }
      }
      *slot = it;
    }
    __syncthreads();
    int item = *slot;
    if (item < 0) break;
    if (item < MIX_LS) scan_item<SCAN_RS>(p, l, item, true, smem);
    else if ((item -= MIX_LS) < MIX_LA) attn_item(p, item, true, smem);
    else if ((item -= MIX_LA) < MIX_CS) scan_item<SCAN_RS_CTX>(p, l, item, false, smem);
    else if ((item -= MIX_CS) < MIX_SG) sgu_item(p, l, item, smem);
    else attn_item(p, item - MIX_SG, false, smem);
  }
}

DEV void phase_fin(PPtr p, int l, unsigned char* smem) {
  u16* As = (u16*)smem; u16* Bs = As + 128 * 72; u16* Zs = Bs + 128 * 72;
  const u16* P = (const u16*)(p->ws + OFF_P);
  const u16* W = (const u16*)(p->ws + OFF_W);
  u16* Y = (u16*)(p->ws + OFF_Y);
  const float* COEF = (const float*)(p->ws + OFF_COEF);
  const int tid = tid_();
  for (int id = vblock(); id < 384 * 4; id += gridDim.x) {
    int mt, nt; tile_map(id, 4, mt, nt);
    const int m0 = mt * 64, c0 = nt * 128;
    __syncthreads();
    for (int it = 0; it < 4; ++it) {
      const int slot = it * 256 + tid, pair = slot >> 3, sub = slot & 7;
      const int tok = pair >> 1, hd = pair & 1;
      const int ch = c0 + hd * 64 + sub * 8, head = nt * 2 + hd;
      const size_t t = (size_t)m0 + tok;
      const bool lat = t >= TCTX;
      const int pos = lat ? (int)((t - TCTX) & 2047) : (int)(t & 255);
      const int L = lat ? 2048 : 256;
      float y0[8], y1[8];
      unpack8(*(const bf16x8*)(Y + t * 512 + ch), y0);
      unpack8(*(const bf16x8*)(Y + (size_t)TT * 512 + t * 512 + ch), y1);
      float sum = 0.f;
#pragma unroll
      for (int i = 0; i < 8; ++i) { y0[i] += y1[i]; sum += y0[i]; }
      sum += dpp_xor1(sum); sum += dpp_xor2(sum); sum += dpp_hmirror(sum);
      const float mu = sum * (1.f / 64.f);
      float sq = 0.f;
#pragma unroll
      for (int i = 0; i < 8; ++i) { y0[i] -= mu; sq += y0[i] * y0[i]; }
      sq += dpp_xor1(sq); sq += dpp_xor2(sq); sq += dpp_hmirror(sq);
      const float rs = rsqrtf(sq * (1.f / 64.f) + GN_EPS);
      float vv[8], n0v[8], n1v[8];
      unpack8(*(const bf16x8*)(P + F_RKV + t * 1536 + 1024 + ch), vv);
      if (pos > 0) unpack8(*(const bf16x8*)(P + F_RKV + (t - 1) * 1536 + 1024 + ch), n0v);
      else {
#pragma unroll
        for (int i = 0; i < 8; ++i) n0v[i] = 0.f;
      }
      if (pos < L - 1) unpack8(*(const bf16x8*)(P + F_RKV + (t + 1) * 1536 + 1024 + ch), n1v);
      else {
#pragma unroll
        for (int i = 0; i < 8; ++i) n1v[i] = 0.f;
      }
      const float cf0 = COEF[(t * 8 + head) * 2], cf1 = COEF[(t * 8 + head) * 2 + 1];
      const float* mu0 = p->rwkv_mu + (size_t)(l * 2) * 1664 + 1024 + ch;
      const float* mu1 = p->rwkv_mu + (size_t)(l * 2 + 1) * 1664 + 1024 + ch;
      const float* lg = p->rwkv_lnx_g + l * 512 + ch;
      const float* lb = p->rwkv_lnx_b + l * 512 + ch;
      float z[8];
#pragma unroll
      for (int i = 0; i < 8; ++i) {
        const float vs0 = vv[i] + mu0[i] * (n0v[i] - vv[i]);
        const float vs1 = vv[i] + mu1[i] * (n1v[i] - vv[i]);
        z[i] = y0[i] * rs * lg[i] + lb[i] + cf0 * vs0 + cf1 * vs1;
      }
      *(bf16x8*)(Zs + tok * 136 + hd * 64 + sub * 8) = pack8(z);
    }
    ASig al{P + F_GD + (size_t)m0 * 128, 128};
    f32x4 acc[2][4]; zero_acc<2>(acc);
    gemm_mainloop<2>(acc, al, W + W_G2 + (size_t)c0 * 128, 128, 128, As, Bs);
    u16* dst = Y + (size_t)m0 * 512 + c0;
    epi_bf16<2>(acc, As, dst, 512, [&](int r, int c, float v) { return v * bf2f(Zs[r * 136 + c]); });
    {
      const float* xr0 = (l == 0) ? (m0 < TCTX ? p->x_prompt + (size_t)m0 * 1024 : p->x_sample + (size_t)(m0 - TCTX) * 1024) : p->out + (size_t)m0 * 1024;
      const float* mod = (const float*)(p->ws + OFF_MOD) + (size_t)(l * 9 + cv_of(m0)) * 6144;
      u16* Pw = (u16*)(p->ws + OFF_P);
#pragma unroll 4
      for (int i = 0; i < 8; ++i) {
        const int c = tid + i * 256, row = c >> 5, cc = c & 31;
        const int hcol = (cc < 16) ? c0 + cc * 8 : 512 + c0 + (cc - 16) * 8;
        bf16x8 hv;
        if (l == 0) { AModX al{xr0, mod + 1024, mod}; hv = al(row, hcol); }
        else {
          const float2 ms = *(const float2*)((const float*)(p->ws + OFF_ST) + (size_t)TT * 2 + ((size_t)m0 + row) * 2);
          const float* xr = xr0 + (size_t)row * 1024 + hcol;
          const float* lg = p->ln2_g + hcol; const float* lb = p->ln2_b + hcol;
          float f[8];
#pragma unroll
          for (int e = 0; e < 8; ++e) {
            const float xv = (xr[e] - ms.x) * ms.y * lg[e] + lb[e];
            f[e] = xv * (1.f + mod[1024 + hcol + e]) + mod[hcol + e];
          }
          hv = pack8(f);
        }
        u16* d = (cc < 16) ? Pw + F_VA + ((size_t)m0 + row) * 512 + c0 + cc * 8 : Y + (size_t)TT * 512 + ((size_t)m0 + row) * 512 + c0 + (cc - 16) * 8;
        *(bf16x8*)d = hv;
      }
    }
  }
}

DEV void phase_merge1(PPtr p, int l, unsigned char* smem) {
  u16* Ct = (u16*)(smem + 32768);
  u16* P = (u16*)(p->ws + OFF_P);
  const u16* W = (const u16*)(p->ws + OFF_W);
  const u16* Y = (const u16*)(p->ws + OFF_Y);
  const u16* HLO = P + F_VA;
  const u16* HHI = Y + (size_t)TT * 512;
  u16* MIX = P + F_RKV;
  TQ tq{(unsigned*)(p->ws + OFF_GQ) + (l * 5 + 1) * 128, 192 * 8, xcc_id(), 0};
  int* slot = (int*)(smem + SMEM_BYTES - 16);
  const int tidq = tid_();
  bool pre = false;
  int id = tq_pull(tq, slot, tidq);
  while (id >= 0) {
    int mt, nt; tile_map(id, 8, mt, nt);
    const int m0 = mt * 128, n0 = nt * 128;
    const int idn = tq_pull(tq, slot, tidq); const bool hn = idn >= 0;
    int mtn = 0, ntn = 0; if (hn) tile_map(idn, 8, mtn, ntn);
    f32x4 mix[4][4]; zero_acc<4>(mix);
#pragma unroll 1
    for (int j = 0; j < 3; ++j) {
      const u16* br = ((j == 0) ? P + F_UA : (j == 1) ? P + F_Q : Y) + (size_t)m0 * 512;
      const u16* wb = W + W_BR + ((size_t)j * 1024 + n0) * 512;
      unsigned sg[4][4][2];
      {
        f32x4 accG[4][4]; zero_acc<4>(accG);
        const u16* wg = W + W_IN + ((size_t)3712 + j * 1024 + n0) * 1024;
        gemm_mainloop_dma<4>(accG, HLO + (size_t)m0 * 512, 512, wg, 1024, 512, smem, pre || j > 0, HHI + (size_t)m0 * 512, 512, wg + 512, 1024);
        gemm_mainloop_dma<4>(accG, HHI + (size_t)m0 * 512, 512, wg + 512, 1024, 512, smem, true, br, 512, wb, 512);
#pragma unroll
        for (int m = 0; m < 4; ++m)
#pragma unroll
          for (int n = 0; n < 4; ++n) {
            sg[m][n][0] = pk2(sigmoidf_(accG[m][n][0]), sigmoidf_(accG[m][n][1]));
            sg[m][n][1] = pk2(sigmoidf_(accG[m][n][2]), sigmoidf_(accG[m][n][3]));
          }
      }
      const u16* nA; const u16* nB;
      if (j < 2) { nA = HLO + (size_t)m0 * 512; nB = W + W_IN + ((size_t)3712 + (j + 1) * 1024 + n0) * 1024; }
      else { nA = hn ? HLO + (size_t)mtn * 128 * 512 : nullptr; nB = W + W_IN + ((size_t)3712 + ntn * 128) * 1024; }
      f32x4 accP[4][4]; zero_acc<4>(accP);
      gemm_mainloop_dma<4, false>(accP, br, 512, wb, 512, 512, smem, true, nA, 512, nB, 1024);
#pragma unroll
      for (int m = 0; m < 4; ++m)
#pragma unroll
        for (int n = 0; n < 4; ++n) {
          mix[m][n][0] += __uint_as_float(sg[m][n][0] << 16) * accP[m][n][0];
          mix[m][n][1] += __uint_as_float(sg[m][n][0] & 0xffff0000u) * accP[m][n][1];
          mix[m][n][2] += __uint_as_float(sg[m][n][1] << 16) * accP[m][n][2];
          mix[m][n][3] += __uint_as_float(sg[m][n][1] & 0xffff0000u) * accP[m][n][3];
        }
    }
    pre = hn;
    u16* dst = MIX + (size_t)m0 * 1024 + n0;
    epi_bf16<4>(mix, Ct, dst, 1024, [](int, int, float v) { return v; });
    id = idn;
  }
}

DEV void phase_merge2(PPtr p, int l, unsigned char* smem) {
  const u16* P = (const u16*)(p->ws + OFF_P);
  const u16* W = (const u16*)(p->ws + OFF_W);
  const float* MOD = (const float*)(p->ws + OFF_MOD);
  const u16* MIX = P + F_RKV;
  TQ tq{(unsigned*)(p->ws + OFF_GQ) + (l * 5 + 2) * 128, 192 * 8, xcc_id(), 0};
  int* slot = (int*)(smem + SMEM_BYTES - 16);
  const int tidq = tid_();
  bool pre = false;
  int id = tq_pull(tq, slot, tidq);
  while (id >= 0) {
    int mt, nt; tile_map(id, 8, mt, nt);
    const int m0 = mt * 128, n0 = nt * 128;
    const int idn = tq_pull(tq, slot, tidq); const bool hn = idn >= 0;
    int mtn = 0, ntn = 0; if (hn) tile_map(idn, 8, mtn, ntn);
    const float* xrow0 = (l == 0) ? (m0 < TCTX ? p->x_prompt + (size_t)m0 * 1024 : p->x_sample + (size_t)(m0 - TCTX) * 1024) : p->out + (size_t)m0 * 1024;
    const float* g1 = MOD + (size_t)(l * 9 + cv_of(m0)) * 6144 + 2048 + n0;
    f32x4 acc[4][4]; zero_acc<4>(acc);
    gemm_mainloop_dma<4>(acc, MIX + (size_t)m0 * 1024, 1024, W + W_OUT + (size_t)n0 * 1024, 1024, 1024, smem, pre,
                         hn ? MIX + (size_t)mtn * 128 * 1024 : nullptr, 1024, W + W_OUT + (size_t)ntn * 128 * 1024, 1024);
    pre = hn;
    float* dst = p->out + (size_t)m0 * 1024 + n0;
    const float* xs = xrow0 + n0;
    const float* st2 = (const float*)(p->ws + OFF_ST) + (size_t)TT * 2 + (size_t)m0 * 2;
    const float* lng = p->ln2_g + n0; const float* lnb = p->ln2_b + n0;
    epi_f32(acc, (float*)(smem + 32768), [&](int r, int c, float4 a) {
      float4 x4 = *(const float4*)(xs + (size_t)r * 1024 + c);
      const float4 g4 = *(const float4*)(g1 + c);
      if (l == 1) {
        const float2 ms = *(const float2*)(st2 + r * 2);
        const float4 lg = *(const float4*)(lng + c), lb = *(const float4*)(lnb + c);
        x4 = make_float4((x4.x - ms.x) * ms.y * lg.x + lb.x, (x4.y - ms.x) * ms.y * lg.y + lb.y, (x4.z - ms.x) * ms.y * lg.z + lb.z, (x4.w - ms.x) * ms.y * lg.w + lb.w);
      }
      *(float4*)(dst + (size_t)r * 1024 + c) = make_float4(ALPHA * x4.x + g4.x * a.x, ALPHA * x4.y + g4.y * a.y, ALPHA * x4.z + g4.z * a.z, ALPHA * x4.w + g4.w * a.w);
    });
    id = idn;
  }
}

DEV void phase_ln(PPtr p, const float* g, const float* bta, const float* modl, int sc_off, int sh_off, float* stats) {
  const int tid = tid_(); const int lane = tid & 63, wave = tid >> 6;
  float4 nv[4];
  {
    const float* r0 = p->out + (size_t)(blockIdx.x * 4 + wave) * 1024;
#pragma unroll
    for (int i = 0; i < 4; ++i) nv[i] = *(const float4*)(r0 + (i * 64 + lane) * 4);
  }
  for (int u = blockIdx.x; u < TT / 4; u += gridDim.x) {
    float* row = p->out + (size_t)(u * 4 + wave) * 1024;
    float4 v[4];
    float sum = 0.f;
#pragma unroll
    for (int i = 0; i < 4; ++i) { v[i] = nv[i]; sum += v[i].x + v[i].y + v[i].z + v[i].w; }
    if (u + (int)gridDim.x < TT / 4) {
      const float* rn = row + (size_t)gridDim.x * 4 * 1024;
#pragma unroll
      for (int i = 0; i < 4; ++i) nv[i] = *(const float4*)(rn + (i * 64 + lane) * 4);
    }
    sum = wave_sum(sum, lane);
    const float mu = sum * (1.f / 1024.f);
    float sq = 0.f;
#pragma unroll
    for (int i = 0; i < 4; ++i) {
      v[i].x -= mu; v[i].y -= mu; v[i].z -= mu; v[i].w -= mu;
      sq += v[i].x * v[i].x + v[i].y * v[i].y + v[i].z * v[i].z + v[i].w * v[i].w;
    }
    sq = wave_sum(sq, lane);
    const float rs = rsqrtf(sq * (1.f / 1024.f) + 1e-5f);
    if (stats && lane == 0) *(float2*)(stats + (size_t)(u * 4 + wave) * 2) = make_float2(mu, rs);
#pragma unroll
    for (int i = 0; i < 4; ++i) {
      const int c = (i * 64 + lane) * 4;
      float4 gg = *(const float4*)(g + c), bb = *(const float4*)(bta + c);
      float4 o4 = make_float4(v[i].x * rs * gg.x + bb.x, v[i].y * rs * gg.y + bb.y, v[i].z * rs * gg.z + bb.z, v[i].w * rs * gg.w + bb.w);
      if (!stats) *(float4*)(row + c) = o4;
      if (modl) {
        const float* mrow = modl + (size_t)cv_of(u * 4 + wave) * 6144;
        const float4 s4 = *(const float4*)(mrow + sc_off + c), h4 = *(const float4*)(mrow + sh_off + c);
        uint2 hv;
        hv.x = pk2(o4.x * (1.f + s4.x) + h4.x, o4.y * (1.f + s4.y) + h4.y);
        hv.y = pk2(o4.z * (1.f + s4.z) + h4.z, o4.w * (1.f + s4.w) + h4.w);
        *(uint2*)((u16*)(p->ws + OFF_H) + (size_t)(u * 4 + wave) * 1024 + c) = hv;
      }
    }
  }
}

DEV void phase_ffn1(PPtr p, int l, unsigned char* smem) {
  u16* Ct = (u16*)(smem + 32768);
  const u16* W = (const u16*)(p->ws + OFF_W);
  const u16* H = (const u16*)(p->ws + OFF_H);
  u16* HID = (u16*)(p->ws + OFF_HID);
  TQ tq{(unsigned*)(p->ws + OFF_GQ) + (l * 5 + 3) * 128, 192 * 32, xcc_id(), 0};
  int* slot = (int*)(smem + SMEM_BYTES - 16);
  const int tidq = tid_();
  bool pre = false;
  int id = tq_pull(tq, slot, tidq);
  while (id >= 0) {
    int mt, nt; tile_map(id, 32, mt, nt);
    const int m0 = mt * 128, n0 = nt * 128;
    const int idn = tq_pull(tq, slot, tidq); const bool hn = idn >= 0;
    int mtn = 0, ntn = 0; if (hn) tile_map(idn, 32, mtn, ntn);
    f32x4 acc[4][4]; zero_acc<4>(acc);
    gemm_mainloop_dma<4>(acc, H + (size_t)m0 * 1024, 1024, W + W_UP + (size_t)n0 * 1024, 1024, 1024, smem, pre,
                         hn ? H + (size_t)mtn * 128 * 1024 : nullptr, 1024, W + W_UP + (size_t)ntn * 128 * 1024, 1024);
    pre = hn;
    u16* dst = HID + (size_t)m0 * 4096 + n0;
    epi_bf16<4>(acc, Ct, dst, 4096, [](int, int, float v) { float q = fmaxf(v, 0.f); return q * q; });
    id = idn;
  }
}

DEV void phase_ffn2(PPtr p, int l, unsigned char* smem) {
  const u16* W = (const u16*)(p->ws + OFF_W);
  const float* MOD = (const float*)(p->ws + OFF_MOD);
  const u16* HID = (const u16*)(p->ws + OFF_HID);
  TQ tq{(unsigned*)(p->ws + OFF_GQ) + (l * 5 + 4) * 128, 192 * 8, xcc_id(), 0};
  int* slot = (int*)(smem + SMEM_BYTES - 16);
  const int tidq = tid_();
  bool pre = false;
  int id = tq_pull(tq, slot, tidq);
  while (id >= 0) {
    int mt, nt; tile_map(id, 8, mt, nt);
    const int m0 = mt * 128, n0 = nt * 128;
    const int idn = tq_pull(tq, slot, tidq); const bool hn = idn >= 0;
    int mtn = 0, ntn = 0; if (hn) tile_map(idn, 8, mtn, ntn);
    const float* g2 = MOD + (size_t)(l * 9 + cv_of(m0)) * 6144 + 5120 + n0;
    f32x4 acc[4][4]; zero_acc<4>(acc);
    gemm_mainloop_dma<4>(acc, HID + (size_t)m0 * 4096, 4096, W + W_DOWN + (size_t)n0 * 4096, 4096, 4096, smem, pre,
                         hn ? HID + (size_t)mtn * 128 * 4096 : nullptr, 4096, W + W_DOWN + (size_t)ntn * 128 * 4096, 4096);
    pre = hn;
    float* dst = p->out + (size_t)m0 * 1024 + n0;
    const float* st1 = (const float*)(p->ws + OFF_ST) + (size_t)m0 * 2;
    const float* lng = p->ln1_g + l * 1024 + n0; const float* lnb = p->ln1_b + l * 1024 + n0;
    epi_f32(acc, (float*)(smem + 32768), [&](int r, int c, float4 a) {
      float* e = dst + (size_t)r * 1024 + c;
      const float2 ms = *(const float2*)(st1 + r * 2);
      const float4 y4 = *(const float4*)e, g4 = *(const float4*)(g2 + c), lg = *(const float4*)(lng + c), lb = *(const float4*)(lnb + c);
      const float4 x4 = make_float4((y4.x - ms.x) * ms.y * lg.x + lb.x, (y4.y - ms.x) * ms.y * lg.y + lb.y, (y4.z - ms.x) * ms.y * lg.z + lb.z, (y4.w - ms.x) * ms.y * lg.w + lb.w);
      *(float4*)e = make_float4(ALPHA * x4.x + g4.x * a.x, ALPHA * x4.y + g4.y * a.y, ALPHA * x4.z + g4.z * a.z, ALPHA * x4.w + g4.w * a.w);
    });
    id = idn;
  }
}

__global__ void __launch_bounds__(NTHR, 2) fwd_megakernel(Params p_unused) {
  __shared__ __attribute__((aligned(16))) unsigned char smem[SMEM_BYTES];
  cg::grid_group grid = cg::this_grid();
  PPtr kp = (PPtr)__builtin_amdgcn_kernarg_segment_ptr();
#define p launder_p(kp)
  {
    unsigned* st0 = (unsigned*)(smem + SMEM_BYTES - 8);
    if (tid_() == 0) {
      st0[0] = 0u; st0[1] = 0u;
      const unsigned x = (unsigned)__builtin_amdgcn_s_getreg((3 << 11) | 20) & 0xFu;
      (void)xb_add((unsigned*)(p->ws + OFF_XB) + XB_XCNT(x), 1u);
    }
    __syncthreads();
  }
#define MODP ((const float*)(p->ws + OFF_MOD))
#pragma unroll 1
  for (int step = 0; step < 21; ++step) {
    const int l = (step - 1) / 10, ph = (step - 1) % 10;
    if (step == 0) {
      for (int u = blockIdx.x; u < 192; u += gridDim.x) mod_unit(p, u, (float*)smem);
      if (p->ws == nullptr) grid.sync();
    } else if (ph == 0) { if (l == 0) phase_convert(p, 0, smem); else continue; }
    else if (ph == 1) phase_inproj(p, l, smem);
    else if (ph == 2) phase_mix(p, l, smem);
    else if (ph == 3) phase_fin(p, l, smem);
    else if (ph == 4) phase_merge1(p, l, smem);
    else if (ph == 5) phase_merge2(p, l, smem);
    else if (ph == 6) phase_ln(p, p->ln1_g + l * 1024, p->ln1_b + l * 1024, MODP + (size_t)l * 9 * 6144, 4096, 3072, (float*)(p->ws + OFF_ST));
    else if (ph == 7) phase_ffn1(p, l, smem);
    else if (ph == 8) phase_ffn2(p, l, smem);
    else {
      phase_ln(p, p->ln2_g + l * 1024, p->ln2_b + l * 1024, l == 0 ? MODP + (size_t)9 * 6144 : nullptr, 1024, 0, l == 0 ? (float*)(p->ws + OFF_ST) + (size_t)TT * 2 : nullptr);
      if (l == 0) phase_convert(p, 1, smem); else break;
    }
    gbar((unsigned*)(p->ws + OFF_XB), smem);
  }
}
#undef MODP
#undef p

extern "C" void kernel_launch(void* const* d_in, const int* in_sizes, int n_in, void* d_out, int out_size, void* d_ws,
                              size_t ws_size, hipStream_t stream) {
  static int grid_blocks = 0;
  if (!grid_blocks) {
    if (n_in != 35 || ws_size < WS_END) { fprintf(stderr, "kernel_launch: bad n_in %d or ws %zu < %zu\n", n_in, ws_size, (size_t)WS_END); grid_blocks = -1; return; }
    int dev = 0, cus = 0, per_cu = 0;
    hipGetDevice(&dev);
    hipDeviceGetAttribute(&cus, hipDeviceAttributeMultiprocessorCount, dev);
    hipOccupancyMaxActiveBlocksPerMultiprocessor(&per_cu, fwd_megakernel, NTHR, 0);
    if (per_cu > 2) per_cu = 2;
    if (per_cu < 1) per_cu = 1;
    grid_blocks = cus * per_cu;
  }
  if (grid_blocks < 0) return;
  hipMemsetAsync((unsigned char*)d_ws + OFF_CUTAB, 0, 65536, stream);
  Params p{};
  const float** pp = (const float**)&p;
  for (int i = 0; i < 35; ++i) pp[i] = (const float*)d_in[i];
  p.out = (float*)d_out;
  p.ws = (unsigned char*)d_ws;
  void* args[] = {&p};
  hipError_t e = hipLaunchCooperativeKernel((void*)fwd_megakernel, dim3(grid_blocks), dim3(NTHR), args, 0, stream);
  if (e != hipSuccess) fprintf(stderr, "cooperative launch failed: %s (grid %d)\n", hipGetErrorString(e), grid_blocks);
}
```

```cpp
#include <hip/hip_runtime.h>
#include <hip/hip_cooperative_groups.h>
#include <cstdio>
namespace cg = cooperative_groups;

typedef unsigned short u16;
typedef __attribute__((ext_vector_type(8))) short bf16x8;
typedef __attribute__((ext_vector_type(4))) short bf16x4;
typedef __attribute__((ext_vector_type(4))) float f32x4;

#define DEV __device__ __forceinline__

constexpr int TCTX = 8192, TLAT = 16384, TT = 24576;
constexpr float ALPHA = 1.41421356237309515f;
constexpr float GN_EPS = 64e-5f;
constexpr int NTHR = 256;

constexpr size_t OFF_MOD = 0;
constexpr size_t OFF_COEF = 524288;
constexpr size_t OFF_CTR = 516096;
constexpr size_t OFF_W = 2101248;
constexpr size_t W_UP = 0, W_DOWN = 4194304, W_IN = 8388608, W_BR = 15335424, W_OUT = 16908288,
                 W_SGU = 17956864, W_W2 = 18022400, W_A2 = 18087936, W_G2 = 18153472, W_TOTAL = 18219008;
constexpr size_t OFF_KC = OFF_W + W_TOTAL * 2;
constexpr size_t KC_LAT = 1048576;
constexpr size_t KC_ELEMS = 3670016;
constexpr size_t OFF_VT = OFF_KC + KC_ELEMS * 2;
constexpr size_t OFF_P = OFF_VT + KC_ELEMS * 2;
constexpr size_t F_UA = 0, F_VA = 12582912, F_Q = 25165824, F_KK = 37748736, F_VV = 40894464, F_RKV = 44040192,
                 F_LORA = 81788928, F_GD = 88080384, P_ELEMS = 91226112;
constexpr size_t OFF_Y = OFF_P + P_ELEMS * 2;
constexpr size_t Y_ELEMS = 25165824;
constexpr size_t OFF_ST = OFF_Y + Y_ELEMS * 2;
constexpr size_t WS_END = OFF_ST + (size_t)2 * TT * 2 * 4;
constexpr size_t OFF_HID = OFF_W + W_IN * 2;
constexpr size_t OFF_H = OFF_Y;
static_assert(OFF_HID + (size_t)TT * 4096 * 2 <= OFF_Y, "HID overlaps H");
constexpr size_t O_NCK = 25165824, O_NCV = 27262976, O_NST = 29360128;

constexpr int SMEM_BYTES = 73728;

struct Params {
  const float *x_prompt, *x_sample, *cache_k, *cache_v, *state_wkv, *c, *c_ctx, *w_ada, *b_ada, *w_in,
      *sgu_ln_g, *sgu_ln_b, *sgu_w, *sgu_b, *q_norm, *k_norm, *rwkv_mu, *rwkv_w0, *rwkv_w2, *rwkv_a0, *rwkv_a2,
      *rwkv_k_k, *rwkv_k_a, *rwkv_r_k, *rwkv_g2, *rwkv_lnx_g, *rwkv_lnx_b, *w_branch, *w_out, *ln1_g, *ln1_b,
      *w_up, *w_down, *ln2_g, *ln2_b;
  float* out;
  unsigned char* ws;
};

typedef __attribute__((ext_vector_type(2))) float f32x2;
typedef __attribute__((ext_vector_type(2))) __bf16 bf16x2_t;
typedef __attribute__((ext_vector_type(4))) unsigned u32x4;
DEV unsigned pk2(float a, float b) { f32x2 v = {a, b}; return __builtin_bit_cast(unsigned, __builtin_convertvector(v, bf16x2_t)); }
DEV u16 f2bf(float f) { return (u16)(pk2(f, 0.f) & 0xffffu); }
DEV float bf2f(u16 h) { return __uint_as_float(((unsigned)h) << 16); }
DEV float bfs(short h) { return __uint_as_float(((unsigned)(u16)h) << 16); }
DEV float frcp(float x) { return __builtin_amdgcn_rcpf(x); }
DEV float sigmoidf_(float x) { return frcp(1.f + __expf(-x)); }
DEV bf16x8 pack8(const float* f) {
  u32x4 r = {pk2(f[0], f[1]), pk2(f[2], f[3]), pk2(f[4], f[5]), pk2(f[6], f[7])};
  return __builtin_bit_cast(bf16x8, r);
}
DEV void unpack8(bf16x8 v, float* f) {
#pragma unroll
  for (int i = 0; i < 8; ++i) f[i] = bfs(v[i]);
}
DEV float dpp_xor1(float x) { return __int_as_float(__builtin_amdgcn_update_dpp(0, __float_as_int(x), 0xB1, 0xF, 0xF, true)); }
DEV float dpp_xor2(float x) { return __int_as_float(__builtin_amdgcn_update_dpp(0, __float_as_int(x), 0x4E, 0xF, 0xF, true)); }
DEV float dpp_hmirror(float x) { return __int_as_float(__builtin_amdgcn_update_dpp(0, __float_as_int(x), 0x141, 0xF, 0xF, true)); }
DEV float dpp_mirror(float x) { return __int_as_float(__builtin_amdgcn_update_dpp(0, __float_as_int(x), 0x140, 0xF, 0xF, true)); }
DEV float shx(float v, int mask, int lane) { return __int_as_float(__builtin_amdgcn_ds_bpermute((lane ^ mask) << 2, __float_as_int(v))); }
DEV float wave_sum(float x, int lane) {
  x += dpp_xor1(x); x += dpp_xor2(x); x += dpp_hmirror(x); x += dpp_mirror(x);
  x += shx(x, 16, lane); x += shx(x, 32, lane);
  return x;
}
DEV f32x4 mfma16(bf16x8 a, bf16x8 b, f32x4 c) { return __builtin_amdgcn_mfma_f32_16x16x32_bf16(a, b, c, 0, 0, 0); }

typedef const __attribute__((address_space(4))) Params* PPtr;
DEV PPtr launder_p(PPtr q) { asm volatile("" : "+s"(q)); return q; }
DEV int tid_() { int t = threadIdx.x; asm volatile("" : "+v"(t)); return t; }
DEV int cv_of(int t) { return t < TCTX ? 0 : 1 + ((t - TCTX) >> 11); }

struct ABf16 {
  const u16* base; int ld;
  DEV bf16x8 operator()(int row, int k) const { return *(const bf16x8*)(base + (size_t)row * ld + k); }
};
struct ASig {
  const u16* base; int ld;
  DEV bf16x8 operator()(int row, int k) const {
    bf16x8 v = *(const bf16x8*)(base + (size_t)row * ld + k);
    float f[8]; unpack8(v, f);
#pragma unroll
    for (int i = 0; i < 8; ++i) f[i] = sigmoidf_(f[i]);
    return pack8(f);
  }
};
struct AModX {
  const float* xrow0; const float* sc; const float* sh;
  DEV bf16x8 operator()(int row, int k) const {
    const float* xr = xrow0 + (size_t)row * 1024 + k;
    float4 x0 = *(const float4*)xr, x1 = *(const float4*)(xr + 4);
    float4 s0 = *(const float4*)(sc + k), s1 = *(const float4*)(sc + k + 4);
    float4 h0 = *(const float4*)(sh + k), h1 = *(const float4*)(sh + k + 4);
    float f[8];
    f[0] = x0.x * (1.f + s0.x) + h0.x; f[1] = x0.y * (1.f + s0.y) + h0.y;
    f[2] = x0.z * (1.f + s0.z) + h0.z; f[3] = x0.w * (1.f + s0.w) + h0.w;
    f[4] = x1.x * (1.f + s1.x) + h1.x; f[5] = x1.y * (1.f + s1.y) + h1.y;
    f[6] = x1.z * (1.f + s1.z) + h1.z; f[7] = x1.w * (1.f + s1.w) + h1.w;
    return pack8(f);
  }
};

template <int MT, class AL>
DEV void gemm_mainloop(f32x4 (&acc)[MT][4], const AL& aload, const u16* __restrict__ Bt, int ldb, int K, u16* As, u16* Bs) {
  const int tid = tid_(), lane = tid & 63, wave = tid >> 6;
  const int wr = wave >> 1, wc = wave & 1, l15 = lane & 15, quad = lane >> 4;
  bf16x8 ra[MT], rb[4];
#pragma unroll
  for (int i = 0; i < MT; ++i) { int c = tid + i * 256; ra[i] = aload(c >> 3, (c & 7) * 8); }
#pragma unroll
  for (int i = 0; i < 4; ++i) { int c = tid + i * 256; rb[i] = *(const bf16x8*)(Bt + (size_t)(c >> 3) * ldb + (c & 7) * 8); }
  const int nk = K >> 6;
#pragma unroll 1
  for (int kt = 0; kt < nk; ++kt) {
    __syncthreads();
#pragma unroll
    for (int i = 0; i < MT; ++i) { int c = tid + i * 256; *(bf16x8*)(As + (c >> 3) * 72 + (c & 7) * 8) = ra[i]; }
#pragma unroll
    for (int i = 0; i < 4; ++i) { int c = tid + i * 256; *(bf16x8*)(Bs + (c >> 3) * 72 + (c & 7) * 8) = rb[i]; }
    __syncthreads();
    if (kt + 1 < nk) {
      const int k0 = (kt + 1) << 6;
#pragma unroll
      for (int i = 0; i < MT; ++i) { int c = tid + i * 256; ra[i] = aload(c >> 3, k0 + (c & 7) * 8); }
#pragma unroll
      for (int i = 0; i < 4; ++i) { int c = tid + i * 256; rb[i] = *(const bf16x8*)(Bt + (size_t)(c >> 3) * ldb + k0 + (c & 7) * 8); }
    }
#pragma unroll
    for (int ks = 0; ks < 2; ++ks) {
      bf16x8 a[MT], b[4];
#pragma unroll
      for (int m = 0; m < MT; ++m) a[m] = *(const bf16x8*)(As + (wr * MT * 16 + m * 16 + l15) * 72 + ks * 32 + quad * 8);
#pragma unroll
      for (int n = 0; n < 4; ++n) b[n] = *(const bf16x8*)(Bs + (wc * 64 + n * 16 + l15) * 72 + ks * 32 + quad * 8);
#pragma unroll
      for (int m = 0; m < MT; ++m)
#pragma unroll
        for (int n = 0; n < 4; ++n) acc[m][n] = mfma16(a[m], b[n], acc[m][n]);
    }
  }
}

template <int MT, bool HOIST = true>
DEV void gemm_mainloop_dma(f32x4 (&acc)[MT][4], const u16* __restrict__ A, int lda, const u16* __restrict__ Bt, int ldb, int K, unsigned char* smem,
                           bool pre = false, const u16* nA = nullptr, int nlda = 0, const u16* nBt = nullptr, int nldb = 0) {
  const int tid = tid_(), lane = tid & 63, wave = tid >> 6;
  const int wr = wave >> 1, wc = wave & 1, l15 = lane & 15, quad = lane >> 4;
  const int prow = tid >> 3, pkc = ((tid & 7) ^ ((tid >> 3) & 7)) * 8;
  const u16* ga = A + (size_t)prow * lda + pkc;
  const u16* gb = Bt + (size_t)prow * ldb + pkc;
  const int nk = K >> 6;
  const int sw = l15 & 7;
  const int slot0 = ((quad) ^ sw) * 16, slot1 = ((4 + quad) ^ sw) * 16;
  const int arow = (wr * MT * 16 + l15) * 128, brow = (wc * 64 + l15) * 128;
  if (!pre) {
    __syncthreads();
    unsigned char* sa = smem + tid * 16;
#pragma unroll
    for (int i = 0; i < MT; ++i) __builtin_amdgcn_global_load_lds((const unsigned*)(ga + (size_t)i * 32 * lda), (unsigned*)(sa + i * 4096), 16, 0, 0);
#pragma unroll
    for (int i = 0; i < 4; ++i) __builtin_amdgcn_global_load_lds((const unsigned*)(gb + (size_t)i * 32 * ldb), (unsigned*)(sa + 16384 + i * 4096), 16, 0, 0);
  }
#pragma unroll 1
  for (int kt = 0; kt < nk; ++kt) {
    asm volatile("s_waitcnt vmcnt(0)" ::: "memory");
    __syncthreads();
    if (kt + 1 < nk) {
      unsigned char* sa = smem + ((kt + 1) & 1) * 32768 + tid * 16;
      const int k0 = (kt + 1) << 6;
#pragma unroll
      for (int i = 0; i < MT; ++i) __builtin_amdgcn_global_load_lds((const unsigned*)(ga + (size_t)i * 32 * lda + k0), (unsigned*)(sa + i * 4096), 16, 0, 0);
#pragma unroll
      for (int i = 0; i < 4; ++i) __builtin_amdgcn_global_load_lds((const unsigned*)(gb + (size_t)i * 32 * ldb + k0), (unsigned*)(sa + 16384 + i * 4096), 16, 0, 0);
    } else if (nA) {
      unsigned char* sa = smem + tid * 16;
      const u16* na = nA + (size_t)prow * nlda + pkc;
      const u16* nb = nBt + (size_t)prow * nldb + pkc;
#pragma unroll
      for (int i = 0; i < MT; ++i) __builtin_amdgcn_global_load_lds((const unsigned*)(na + (size_t)i * 32 * nlda), (unsigned*)(sa + i * 4096), 16, 0, 0);
#pragma unroll
      for (int i = 0; i < 4; ++i) __builtin_amdgcn_global_load_lds((const unsigned*)(nb + (size_t)i * 32 * nldb), (unsigned*)(sa + 16384 + i * 4096), 16, 0, 0);
    }
    const unsigned char* ab = smem + (kt & 1) * 32768;
    const unsigned char* bb = ab + 16384;
    if (!HOIST) {
#pragma unroll
      for (int ks = 0; ks < 2; ++ks) {
        const int slot = ks ? slot1 : slot0;
        bf16x8 a[MT], b[4];
#pragma unroll
        for (int m = 0; m < MT; ++m) a[m] = *(const bf16x8*)(ab + arow + m * 2048 + slot);
#pragma unroll
        for (int n = 0; n < 4; ++n) b[n] = *(const bf16x8*)(bb + brow + n * 2048 + slot);
        __builtin_amdgcn_sched_barrier(0);
#pragma unroll
        for (int m = 0; m < MT; ++m)
#pragma unroll
          for (int n = 0; n < 4; ++n) acc[m][n] = mfma16(a[m], b[n], acc[m][n]);
        __builtin_amdgcn_sched_barrier(0);
      }
      continue;
    }
    bf16x8 a0[MT], b0[4], a1[MT], b1[4];
#pragma unroll
    for (int m = 0; m < MT; ++m) a0[m] = *(const bf16x8*)(ab + arow + m * 2048 + slot0);
#pragma unroll
    for (int n = 0; n < 4; ++n) b0[n] = *(const bf16x8*)(bb + brow + n * 2048 + slot0);
#pragma unroll
    for (int m = 0; m < MT; ++m) a1[m] = *(const bf16x8*)(ab + arow + m * 2048 + slot1);
#pragma unroll
    for (int n = 0; n < 4; ++n) b1[n] = *(const bf16x8*)(bb + brow + n * 2048 + slot1);
    __builtin_amdgcn_sched_barrier(0);
#pragma unroll
    for (int m = 0; m < MT; ++m)
#pragma unroll
      for (int n = 0; n < 4; ++n) acc[m][n] = mfma16(a0[m], b0[n], acc[m][n]);
#pragma unroll
    for (int m = 0; m < MT; ++m)
#pragma unroll
      for (int n = 0; n < 4; ++n) acc[m][n] = mfma16(a1[m], b1[n], acc[m][n]);
  }
}

template <int MT>
DEV void zero_acc(f32x4 (&acc)[MT][4]) {
#pragma unroll
  for (int m = 0; m < MT; ++m)
#pragma unroll
    for (int n = 0; n < 4; ++n) acc[m][n] = (f32x4){0.f, 0.f, 0.f, 0.f};
}

template <int MT, class F>
DEV void epi_foreach(f32x4 (&acc)[MT][4], F f) {
  const int tid = tid_(); const int lane = tid & 63, wave = tid >> 6;
  const int wr = wave >> 1, wc = wave & 1, l15 = lane & 15, quad = lane >> 4;
#pragma unroll
  for (int m = 0; m < MT; ++m)
#pragma unroll
    for (int n = 0; n < 4; ++n)
#pragma unroll
      for (int j = 0; j < 4; ++j) f(wr * MT * 16 + m * 16 + quad * 4 + j, wc * 64 + n * 16 + l15, acc[m][n][j]);
}

template <int MT, class F>
DEV void epi_bf16(f32x4 (&acc)[MT][4], u16* Ct, u16* dst, int ld, F f) {
  __syncthreads();
  epi_foreach<MT>(acc, [&](int r, int c, float v) { Ct[r * 136 + c] = f2bf(f(r, c, v)); });
  __syncthreads();
  const int tid = tid_();
#pragma unroll
  for (int i = 0; i < MT * 2; ++i) {
    const int c = tid + i * 256, row = c >> 4, cc = (c & 15) * 8;
    *(bf16x8*)(dst + (size_t)row * ld + cc) = *(const bf16x8*)(Ct + row * 136 + cc);
  }
}
template <class G>
DEV void epi_f32(f32x4 (&acc)[4][4], float* Cf, G g) {
  const int tid = tid_(), lane = tid & 63, wave = tid >> 6;
  const int wr = wave >> 1, wc = wave & 1, l15 = lane & 15, quad = lane >> 4;
#pragma unroll 1
  for (int half = 0; half < 2; ++half) {
    __syncthreads();
    if (wr == half) {
#pragma unroll
      for (int m = 0; m < 4; ++m)
#pragma unroll
        for (int n = 0; n < 4; ++n)
#pragma unroll
          for (int j = 0; j < 4; ++j) Cf[(m * 16 + quad * 4 + j) * 132 + wc * 64 + n * 16 + l15] = acc[m][n][j];
    }
    __syncthreads();
#pragma unroll 4
    for (int i = 0; i < 8; ++i) {
      const int c = tid + i * 256, row = c >> 5, cc = (c & 31) * 4;
      g(half * 64 + row, cc, *(const float4*)(Cf + row * 132 + cc));
    }
  }
}

#define XB_TMO 128
#define XB_XCNT(j) (256 + 64 * (j))
#define XB_XSUB(j) (1280 + 64 * (j))
#define XB_XGEN(j) (2304 + 64 * (j))
#define XB_TOP 3328
#define XB_TOPGEN 3392
#define XB_SPIN_CAP (1u << 20)
constexpr size_t OFF_XB = 499712;
DEV unsigned xb_ld(unsigned* q) { return __hip_atomic_load(q, __ATOMIC_RELAXED, __HIP_MEMORY_SCOPE_AGENT); }
DEV unsigned xb_add(unsigned* q, unsigned v) { return __hip_atomic_fetch_add(q, v, __ATOMIC_RELAXED, __HIP_MEMORY_SCOPE_AGENT); }
#define XB_SPIN(cond, bar)                                                                                         \
  do {                                                                                                             \
    unsigned _sp = 0;                                                                                              \
    while (cond) {                                                                                                 \
      __builtin_amdgcn_s_sleep(1);                                                                                 \
      if ((++_sp & 255u) == 0u) { if (xb_ld(&(bar)[XB_TMO])) break; if (_sp > XB_SPIN_CAP) { atomicAdd(&(bar)[XB_TMO], 1u); break; } } \
    }                                                                                                              \
  } while (0)
DEV void xb_complete(unsigned* bar, unsigned x, unsigned& nloc, unsigned& nx) {
  const unsigned G = gridDim.x;
  unsigned sum, cnt, mine, sp = 0u;
  for (;;) {
    sum = 0u; cnt = 0u; mine = 0u;
#pragma unroll 1
    for (unsigned j = 0; j < 16; ++j) { const unsigned c = xb_ld(&bar[XB_XCNT(j)]); sum += c; cnt += (c > 0u) ? 1u : 0u; mine = (j == x) ? c : mine; }
    if (sum == G) break;
    __builtin_amdgcn_s_sleep(1);
    if ((++sp & 255u) == 0u) { if (xb_ld(&bar[XB_TMO])) break; if (sp > XB_SPIN_CAP) { atomicAdd(&bar[XB_TMO], 1u); break; } }
  }
  nloc = mine > 0u ? mine : 1u; nx = cnt > 0u ? cnt : 1u;
}
DEV void gbar(unsigned* bar, unsigned char* smem) {
  unsigned* st = (unsigned*)(smem + SMEM_BYTES - 8);
  asm volatile("s_waitcnt vmcnt(0)" ::: "memory");
  __syncthreads();
  if (tid_() == 0) {
    __builtin_amdgcn_s_waitcnt(0);
    const unsigned x = (unsigned)__builtin_amdgcn_s_getreg((3 << 11) | 20) & 0xFu;
    unsigned nloc = st[0], nx = st[1];
    if (nloc == 0u) { xb_complete(bar, x, nloc, nx); st[0] = nloc; st[1] = nx; }
    const unsigned old = xb_add(&bar[XB_XSUB(x)], 1u);
    const unsigned gen = old / nloc;
    if (old + 1u == (gen + 1u) * nloc) {
      __builtin_amdgcn_fence(__ATOMIC_RELEASE, "agent");
      asm volatile("s_waitcnt vmcnt(0)" ::: "memory");
      const unsigned og = xb_add(&bar[XB_TOP], 1u);
      const unsigned tg = og / nx;
      if (og + 1u == (tg + 1u) * nx) xb_add(&bar[XB_TOPGEN], 1u);
      else XB_SPIN(xb_ld(&bar[XB_TOPGEN]) == tg, bar);
      __builtin_amdgcn_fence(__ATOMIC_ACQUIRE, "agent");
      xb_add(&bar[XB_XGEN(x)], 1u);
      asm volatile("s_waitcnt vmcnt(0)" ::: "memory");
    } else {
      XB_SPIN(xb_ld(&bar[XB_XGEN(x)]) == gen, bar);
      __builtin_amdgcn_fence(__ATOMIC_ACQUIRE, "agent");
      asm volatile("s_waitcnt vmcnt(0)" ::: "memory");
    }
  }
  __syncthreads();
}

DEV void transpose_tile(const float* __restrict__ src, int K, int N, u16* __restrict__ dst, int tile, float* sm) {
  const int tn = N >> 6;
  const int k0 = (tile / tn) * 64, n0 = (tile % tn) * 64;
  const int tid = tid_();
  __syncthreads();
#pragma unroll
  for (int i = 0; i < 4; ++i) {
    const int k = i * 16 + (tid >> 4), n = (tid & 15) * 4;
    const float4 v4 = *(const float4*)(src + (size_t)(k0 + k) * N + n0 + n);
    sm[k * 65 + n] = v4.x; sm[k * 65 + n + 1] = v4.y; sm[k * 65 + n + 2] = v4.z; sm[k * 65 + n + 3] = v4.w;
  }
  __syncthreads();
  const int n = tid >> 2, kc = (tid & 3) * 16;
  bf16x8 o0, o1;
#pragma unroll
  for (int i = 0; i < 8; ++i) { o0[i] = (short)f2bf(sm[(kc + i) * 65 + n]); o1[i] = (short)f2bf(sm[(kc + 8 + i) * 65 + n]); }
  u16* d = dst + (size_t)(n0 + n) * K + k0 + kc;
  *(bf16x8*)d = o0; *(bf16x8*)(d + 8) = o1;
}

DEV void mod_unit(PPtr p, int u, float* sm) {
  const int l2 = u / 96, n0 = (u % 96) * 64, tid = tid_();
  float* sc = sm; float* red = sm + 9216;
  __syncthreads();
  for (int i = tid; i < 9216; i += 256) {
    int cv = i >> 10, k = i & 1023;
    float x = cv == 0 ? p->c_ctx[k] : p->c[(cv - 1) * 1024 + k];
    sc[i] = x / (1.f + __expf(-x));
  }
  __syncthreads();
  const int kq = tid >> 6, col = tid & 63;
  float acc[9];
#pragma unroll
  for (int cv = 0; cv < 9; ++cv) acc[cv] = 0.f;
  const float* w = p->w_ada + ((size_t)l2 * 1024 + kq * 256) * 6144 + n0 + col;
#pragma unroll 4
  for (int k = 0; k < 256; ++k) {
    float wv = w[(size_t)k * 6144];
#pragma unroll
    for (int cv = 0; cv < 9; ++cv) acc[cv] += sc[cv * 1024 + kq * 256 + k] * wv;
  }
#pragma unroll
  for (int cv = 0; cv < 9; ++cv) red[(kq * 9 + cv) * 64 + col] = acc[cv];
  __syncthreads();
  float* MOD = (float*)(p->ws + OFF_MOD);
  for (int i = tid; i < 576; i += 256) {
    int cv = i >> 6, cc = i & 63;
    float s = red[(0 * 9 + cv) * 64 + cc] + red[(1 * 9 + cv) * 64 + cc] + red[(2 * 9 + cv) * 64 + cc] + red[(3 * 9 + cv) * 64 + cc];
    MOD[(size_t)(l2 * 9 + cv) * 6144 + n0 + cc] = s + p->b_ada[l2 * 6144 + n0 + cc];
  }
}

DEV void phase_convert(PPtr p, int l, unsigned char* smem) {
  float* sm = (float*)smem;
  u16* W = (u16*)(p->ws + OFF_W);
  const int tidc = tid_();
  const int total = (l == 0) ? 4448 + 1536 : 4448;
  for (int id = blockIdx.x; id < total; id += gridDim.x) {
    if (id < 1696) transpose_tile(p->w_in + (size_t)l * 1024 * 6784, 1024, 6784, W + W_IN, id, sm);
    else if (id < 2080) { int j = (id - 1696) >> 7; transpose_tile(p->w_branch + (size_t)(l * 3 + j) * 512 * 1024, 512, 1024, W + W_BR + (size_t)j * 1024 * 512, (id - 1696) & 127, sm); }
    else if (id < 2336) transpose_tile(p->w_out + (size_t)l * 1024 * 1024, 1024, 1024, W + W_OUT, id - 2080, sm);
    else if (id < 3360) transpose_tile(p->w_up + (size_t)l * 1024 * 4096, 1024, 4096, W + W_UP, id - 2336, sm);
    else if (id < 4384) transpose_tile(p->w_down + (size_t)l * 4096 * 1024, 4096, 1024, W + W_DOWN, id - 3360, sm);
    else if (id < 4400) { int d = (id - 4384) >> 3; transpose_tile(p->rwkv_w2 + (size_t)(l * 2 + d) * 64 * 512, 64, 512, W + W_W2 + (size_t)d * 512 * 64, (id - 4384) & 7, sm); }
    else if (id < 4416) { int d = (id - 4400) >> 3; transpose_tile(p->rwkv_a2 + (size_t)(l * 2 + d) * 64 * 512, 64, 512, W + W_A2 + (size_t)d * 512 * 64, (id - 4400) & 7, sm); }
    else if (id < 4432) transpose_tile(p->rwkv_g2 + (size_t)l * 128 * 512, 128, 512, W + W_G2, id - 4416, sm);
    else if (id < 4448) {
      const float* src = p->sgu_w + (size_t)l * 65536 + (id - 4432) * 4096 + tidc * 16;
      u16* dst = W + W_SGU + (id - 4432) * 4096 + tidc * 16;
      float f[16];
#pragma unroll
      for (int i = 0; i < 4; ++i) { float4 v = *(const float4*)(src + i * 4); f[i * 4] = v.x; f[i * 4 + 1] = v.y; f[i * 4 + 2] = v.z; f[i * 4 + 3] = v.w; }
      *(bf16x8*)dst = pack8(f); *(bf16x8*)(dst + 8) = pack8(f + 8);
    } else {
      const int r0 = (id - 4448) * 16;
      const float* xr0 = r0 < TCTX ? p->x_prompt + (size_t)r0 * 1024 : p->x_sample + (size_t)(r0 - TCTX) * 1024;
      const float* mod = (const float*)(p->ws + OFF_MOD) + (size_t)cv_of(r0) * 6144;
      u16* H = (u16*)(p->ws + OFF_H) + (size_t)r0 * 1024;
#pragma unroll 2
      for (int i = 0; i < 8; ++i) {
        const int c = tidc + i * 256, row = c >> 7, kc = (c & 127) * 8;
        AModX al{xr0, mod + 1024, mod};
        *(bf16x8*)(H + (size_t)row * 1024 + kc) = al(row, kc);
      }
    }
  }
}

DEV int vblock() { const int G = gridDim.x, b = blockIdx.x; return (G & 7) == 0 ? (b & 7) * (G >> 3) + (b >> 3) : b; }
DEV void tile_map(int id, int NT, int& mt, int& nt) { const int g = id / (8 * NT), r = id - g * 8 * NT; nt = r >> 3; mt = g * 8 + (r & 7); }

constexpr size_t OFF_GQ = 491520;
struct TQ { unsigned* q; int nt; int xcc; int tries; };
DEV int xcc_id() { return (int)(__builtin_amdgcn_s_getreg((3 << 11) | 20) & 7u); }
DEV int tq_pull(TQ& t, int* slot, int tid) {
  __syncthreads();
  if (tid == 0) {
    int id = -1;
    while (t.tries < 8) {
      const int x = (t.xcc + t.tries) & 7;
      const int start = (t.nt * x) >> 3, end = (t.nt * (x + 1)) >> 3;
      const int k = (int)atomicAdd(t.q + x * 16, 1u);
      if (start + k < end) { id = start + k; break; }
      ++t.tries;
    }
    *slot = id;
  }
  __syncthreads();
  return *slot;
}

DEV void inproj_qk_epilogue(PPtr p, int l, f32x4 (&acc)[4][4], u16* Ct, int m0, int nt) {
  __syncthreads();
  epi_foreach<4>(acc, [&](int r, int c, float v) { Ct[r * 136 + c] = f2bf(v); });
  __syncthreads();
  const int tid = tid_(), s = tid & 7;
  const bool isk = nt == 12;
  u16* Qf = (u16*)(p->ws + OFF_P) + F_Q;
  u16* KC = (u16*)(p->ws + OFF_KC);
  const float* g = (isk ? p->k_norm : p->q_norm) + l * 64 + s * 8;
#pragma unroll 1
  for (int it = 0; it < 8; ++it) {
    const int slot = it * 256 + tid, pair = slot >> 3, row = pair >> 1, hd = pair & 1;
    const int t = m0 + row;
    const bool lat = t >= TCTX;
    const int b = lat ? (t - TCTX) >> 11 : t >> 8;
    const int pos = lat ? (t - TCTX) & 2047 : t & 255;
    float f[8]; unpack8(*(const bf16x8*)(Ct + row * 136 + hd * 64 + s * 8), f);
    float ss = 0.f;
#pragma unroll
    for (int i = 0; i < 8; ++i) ss += f[i] * f[i];
    ss += dpp_xor1(ss); ss += dpp_xor2(ss); ss += dpp_hmirror(ss);
    const float rs = rsqrtf(ss * (1.f / 64.f) + 1e-6f);
#pragma unroll
    for (int i = 0; i < 8; ++i) f[i] = f[i] * rs * g[i];
    if (lat) {
      const float posv = (float)((s < 4) ? (pos >> 6) : (pos & 63));
#pragma unroll
      for (int i = 0; i < 8; ++i) {
        const float fi = (float)((s & 1) * 8 + i);
        const float ang = posv * exp2f(-fi * (13.287712379549449f / 16.f));
        const float cs = __cosf(ang), sn = __sinf(ang);
        const float pf = dpp_xor2(f[i]);
        f[i] = (s & 2) ? (f[i] * cs + pf * sn) : (f[i] * cs - pf * sn);
      }
    }
    const bf16x8 o = pack8(f);
    if (!isk) *(bf16x8*)(Qf + (size_t)t * 512 + (nt - 8) * 128 + hd * 64 + s * 8) = o;
    else if (lat) *(bf16x8*)(KC + KC_LAT + ((size_t)(b * 2 + hd) * 2560 + 512 + pos) * 64 + s * 8) = o;
    else {
      *(bf16x8*)(KC + ((size_t)(b * 2 + hd) * 256 + pos) * 64 + s * 8) = o;
      float* d = p->out + O_NCK + ((((size_t)b * 2 + l) * 256 + pos) * 2 + hd) * 64 + s * 8;
      *(float4*)d = make_float4(f[0], f[1], f[2], f[3]);
      *(float4*)(d + 4) = make_float4(f[4], f[5], f[6], f[7]);
    }
  }
}
DEV void inproj_v_epilogue(PPtr p, int l, f32x4 (&acc)[4][4], u16* Ct, int m0) {
  __syncthreads();
  epi_foreach<4>(acc, [&](int r, int c, float v) { Ct[r * 136 + c] = f2bf(v); });
  __syncthreads();
  const int tid = tid_();
  u16* VT = (u16*)(p->ws + OFF_VT);
  const bool lat = m0 >= TCTX;
  const int b = lat ? (m0 - TCTX) >> 11 : m0 >> 8;
  const int pos0 = lat ? (m0 - TCTX) & 2047 : m0 & 255;
  if (!lat) {
#pragma unroll 2
    for (int i = 0; i < 8; ++i) {
      const int c = tid + i * 256, row = c >> 4, cc = (c & 15) * 8;
      float f[8]; unpack8(*(const bf16x8*)(Ct + row * 136 + cc), f);
      float* d = p->out + O_NCV + ((((size_t)b * 2 + l) * 256 + pos0 + row) * 2 + (cc >> 6)) * 64 + (cc & 63);
      *(float4*)d = make_float4(f[0], f[1], f[2], f[3]);
      *(float4*)(d + 4) = make_float4(f[4], f[5], f[6], f[7]);
    }
  }
#pragma unroll 2
  for (int i = 0; i < 8; ++i) {
    const int c = tid + i * 256, kvh = c >> 10, d = (c >> 4) & 63, kc = c & 15;
    bf16x8 o;
#pragma unroll
    for (int e = 0; e < 8; ++e) o[e] = (short)Ct[(kc * 8 + e) * 136 + kvh * 64 + d];
    u16* dst = lat ? VT + KC_LAT + ((size_t)(b * 2 + kvh) * 64 + d) * 2560 + 512 + pos0 + kc * 8
                   : VT + ((size_t)(b * 2 + kvh) * 64 + d) * 256 + pos0 + kc * 8;
    *(bf16x8*)dst = o;
  }
}
DEV void cache_tile(PPtr p, int l, int u, unsigned char* smem) {
  u16* KC = (u16*)(p->ws + OFF_KC);
  u16* VT = (u16*)(p->ws + OFF_VT);
  const int tid = tid_();
  const int b = u >> 4, kvh = (u >> 3) & 1, kb = u & 7;
  u16* tile = (u16*)smem;
  const int key = tid >> 2, dc = (tid & 3) * 16;
  float f[16], fk[16];
  __syncthreads();
  const int pk = kb * 64 + key;
  const float* sv = p->cache_v + (((size_t)(b * 2 + l) * 512 + pk) * 2 + kvh) * 64 + dc;
  const float* sk = p->cache_k + (((size_t)(b * 2 + l) * 512 + pk) * 2 + kvh) * 64 + dc;
#pragma unroll
  for (int i = 0; i < 4; ++i) {
    float4 v = *(const float4*)(sv + i * 4); f[i * 4] = v.x; f[i * 4 + 1] = v.y; f[i * 4 + 2] = v.z; f[i * 4 + 3] = v.w;
    float4 k = *(const float4*)(sk + i * 4); fk[i * 4] = k.x; fk[i * 4 + 1] = k.y; fk[i * 4 + 2] = k.z; fk[i * 4 + 3] = k.w;
  }
  u16* kd = KC + KC_LAT + ((size_t)(b * 2 + kvh) * 2560 + pk) * 64 + dc;
  *(bf16x8*)kd = pack8(fk); *(bf16x8*)(kd + 8) = pack8(fk + 8);
#pragma unroll
  for (int i = 0; i < 16; ++i) tile[(dc + i) * 72 + key] = f2bf(f[i]);
  __syncthreads();
  const int d = tid >> 2, kc = (tid & 3) * 16;
  bf16x8 o0 = *(const bf16x8*)(tile + d * 72 + kc), o1 = *(const bf16x8*)(tile + d * 72 + kc + 8);
  u16* dst = VT + KC_LAT + ((size_t)(b * 2 + kvh) * 64 + d) * 2560 + kb * 64 + kc;
  *(bf16x8*)dst = o0; *(bf16x8*)(dst + 8) = o1;
}

DEV void phase_inproj(PPtr p, int l, unsigned char* smem) {
  u16* Ct = (u16*)(smem + 32768);
  const u16* W = (const u16*)(p->ws + OFF_W);
  const u16* H = (const u16*)(p->ws + OFF_H);
  u16* P = (u16*)(p->ws + OFF_P);
  TQ tq{(unsigned*)(p->ws + OFF_GQ) + (l * 5 + 0) * 128, 192 * 29, xcc_id(), 0};
  int* slot = (int*)(smem + SMEM_BYTES - 16);
  const int tidq = tid_();
  bool pre = false;
  int id = tq_pull(tq, slot, tidq);
  while (id >= 0) {
    int mt, nt; tile_map(id, 29, mt, nt);
    const int m0 = mt * 128, n0 = nt * 128;
    const int idn = tq_pull(tq, slot, tidq); const bool hn = idn >= 0;
    int mtn = 0, ntn = 0; if (hn) tile_map(idn, 29, mtn, ntn);
    f32x4 acc[4][4]; zero_acc<4>(acc);
    gemm_mainloop_dma<4>(acc, H + (size_t)m0 * 1024, 1024, W + W_IN + (size_t)n0 * 1024, 1024, 1024, smem, pre,
                         hn ? H + (size_t)mtn * 128 * 1024 : nullptr, 1024, W + W_IN + (size_t)ntn * 128 * 1024, 1024);
    pre = hn;
    if (nt >= 8 && nt <= 12) { inproj_qk_epilogue(p, l, acc, Ct, m0, nt); id = idn; continue; }
    if (nt == 13) { inproj_v_epilogue(p, l, acc, Ct, m0); id = idn; continue; }
    u16* dst; int ld;
    if (n0 < 512) { dst = P + F_UA + n0; ld = 512; }
    else if (n0 < 1024) { dst = P + F_VA + (n0 - 512); ld = 512; }
    else if (n0 < 1536) { dst = P + F_Q + (n0 - 1024); ld = 512; }
    else if (n0 < 1664) { dst = P + F_KK; ld = 128; }
    else if (n0 < 1792) { dst = P + F_VV; ld = 128; }
    else if (n0 < 3328) { dst = P + F_RKV + (n0 - 1792); ld = 1536; }
    else if (n0 < 3584) { dst = P + F_LORA + (n0 - 3328); ld = 256; }
    else { dst = P + F_GD; ld = 128; }
    dst += (size_t)m0 * ld;
    epi_bf16<4>(acc, Ct, dst, ld, [](int, int, float v) { return v; });
    id = idn;
  }
  for (int u = blockIdx.x; u < 128; u += gridDim.x) cache_tile(p, l, u, smem);
}


DEV void attn_item(PPtr p, int item, bool lat, unsigned char* smem) {
  u16* Ks = (u16*)smem; u16* Vs = Ks + 64 * 72;
  u16* P = (u16*)(p->ws + OFF_P);
  const int tid = tid_(), lane = tid & 63, wave = tid >> 6, l15 = lane & 15, quad = lane >> 4;
  int b, kvh, qb, LK; size_t tq0; const u16 *Kc, *VTc;
  if (lat) {
    b = item >> 7; kvh = (item >> 6) & 1; qb = item & 63; LK = 2560;
    tq0 = TCTX + (size_t)b * 2048 + qb * 32;
    Kc = (const u16*)(p->ws + OFF_KC) + KC_LAT + (size_t)(b * 2 + kvh) * 2560 * 64;
    VTc = (const u16*)(p->ws + OFF_VT) + KC_LAT + (size_t)(b * 2 + kvh) * 64 * 2560;
  } else {
    b = item >> 4; kvh = (item >> 3) & 1; qb = item & 7; LK = 256;
    tq0 = (size_t)b * 256 + qb * 32;
    Kc = (const u16*)(p->ws + OFF_KC) + (size_t)(b * 2 + kvh) * 256 * 64;
    VTc = (const u16*)(p->ws + OFF_VT) + (size_t)(b * 2 + kvh) * 64 * 256;
  }
  const int hq = kvh * 4 + wave;
  bf16x8 qf[2][2];
#pragma unroll
  for (int qt = 0; qt < 2; ++qt)
#pragma unroll
    for (int ks = 0; ks < 2; ++ks) qf[qt][ks] = *(const bf16x8*)(P + F_Q + (tq0 + qt * 16 + l15) * 512 + hq * 64 + ks * 32 + quad * 8);
  f32x4 o[4][2];
#pragma unroll
  for (int dt = 0; dt < 4; ++dt)
#pragma unroll
    for (int qt = 0; qt < 2; ++qt) o[dt][qt] = (f32x4){0.f, 0.f, 0.f, 0.f};
  float mrow[2] = {-1e30f, -1e30f}, lrow[2] = {0.f, 0.f};
  const float C = 0.125f * 1.4426950408889634f;
  bf16x8 rk[2], rv[2];
#pragma unroll
  for (int i = 0; i < 2; ++i) {
    int c = tid + i * 256, r = c >> 3, cc = (c & 7) * 8;
    rk[i] = *(const bf16x8*)(Kc + (size_t)r * 64 + cc);
    rv[i] = *(const bf16x8*)(VTc + (size_t)r * LK + cc);
  }
  const int nt = LK >> 6;
  for (int kt = 0; kt < nt; ++kt) {
    __syncthreads();
#pragma unroll
    for (int i = 0; i < 2; ++i) {
      int c = tid + i * 256, r = c >> 3, cc = (c & 7) * 8;
      *(bf16x8*)(Ks + r * 72 + cc) = rk[i];
      *(bf16x8*)(Vs + r * 72 + cc) = rv[i];
    }
    __syncthreads();
    if (kt + 1 < nt) {
      const int key0 = (kt + 1) * 64;
#pragma unroll
      for (int i = 0; i < 2; ++i) {
        int c = tid + i * 256, r = c >> 3, cc = (c & 7) * 8;
        rk[i] = *(const bf16x8*)(Kc + (size_t)(key0 + r) * 64 + cc);
        rv[i] = *(const bf16x8*)(VTc + (size_t)r * LK + key0 + cc);
      }
    }
    f32x4 s[4][2];
#pragma unroll
    for (int nk = 0; nk < 4; ++nk)
#pragma unroll
      for (int qt = 0; qt < 2; ++qt) s[nk][qt] = (f32x4){0.f, 0.f, 0.f, 0.f};
#pragma unroll
    for (int ks = 0; ks < 2; ++ks)
#pragma unroll
      for (int nk = 0; nk < 4; ++nk) {
        bf16x8 a = *(const bf16x8*)(Ks + (nk * 16 + l15) * 72 + ks * 32 + quad * 8);
#pragma unroll
        for (int qt = 0; qt < 2; ++qt) s[nk][qt] = mfma16(a, qf[qt][ks], s[nk][qt]);
      }
#pragma unroll
    for (int qt = 0; qt < 2; ++qt) {
      float mx = -1e30f;
#pragma unroll
      for (int nk = 0; nk < 4; ++nk)
#pragma unroll
        for (int j = 0; j < 4; ++j) mx = fmaxf(mx, s[nk][qt][j]);
      mx = fmaxf(mx, shx(mx, 16, lane)); mx = fmaxf(mx, shx(mx, 32, lane));
      const float mnew = fmaxf(mrow[qt], mx);
      const float alpha = __builtin_amdgcn_exp2f((mrow[qt] - mnew) * C);
      mrow[qt] = mnew;
      lrow[qt] *= alpha;
#pragma unroll
      for (int dt = 0; dt < 4; ++dt) { o[dt][qt][0] *= alpha; o[dt][qt][1] *= alpha; o[dt][qt][2] *= alpha; o[dt][qt][3] *= alpha; }
      const float nmc = -mrow[qt] * C;
      float ls = 0.f;
#pragma unroll
      for (int nk = 0; nk < 4; ++nk)
#pragma unroll
        for (int j = 0; j < 4; ++j) { float pv = __builtin_amdgcn_exp2f(__builtin_fmaf(s[nk][qt][j], C, nmc)); ls += pv; s[nk][qt][j] = pv; }
      lrow[qt] += ls;
    }
#pragma unroll
    for (int ks = 0; ks < 2; ++ks) {
      bf16x8 pf[2];
#pragma unroll
      for (int qt = 0; qt < 2; ++qt) {
#pragma unroll
        for (int j = 0; j < 4; ++j) { pf[qt][j] = (short)f2bf(s[2 * ks][qt][j]); pf[qt][4 + j] = (short)f2bf(s[2 * ks + 1][qt][j]); }
      }
#pragma unroll
      for (int dt = 0; dt < 4; ++dt) {
        const u16* vr = Vs + (dt * 16 + l15) * 72 + quad * 4;
        bf16x4 v0 = *(const bf16x4*)(vr + (2 * ks) * 16), v1 = *(const bf16x4*)(vr + (2 * ks + 1) * 16);
        bf16x8 a;
        a[0] = v0[0]; a[1] = v0[1]; a[2] = v0[2]; a[3] = v0[3]; a[4] = v1[0]; a[5] = v1[1]; a[6] = v1[2]; a[7] = v1[3];
#pragma unroll
        for (int qt = 0; qt < 2; ++qt) o[dt][qt] = mfma16(a, pf[qt], o[dt][qt]);
      }
    }
  }
#pragma unroll
  for (int qt = 0; qt < 2; ++qt) {
    float lsum = lrow[qt];
    lsum += shx(lsum, 16, lane); lsum += shx(lsum, 32, lane);
    const float inv = frcp(lsum);
#pragma unroll
    for (int dt = 0; dt < 4; ++dt) {
      bf16x4 ov;
#pragma unroll
      for (int j = 0; j < 4; ++j) ov[j] = (short)f2bf(o[dt][qt][j] * inv);
      *(bf16x4*)(P + F_Q + (tq0 + qt * 16 + l15) * 512 + hq * 64 + dt * 16 + quad * 4) = ov;
    }
  }
}

DEV void sgu_item(PPtr p, int l, int item, unsigned char* smem) {
  u16* VnT = (u16*)smem;
  float* stats = (float*)(smem + 128 * 136 * 2);
  u16* P = (u16*)(p->ws + OFF_P);
  const u16* Wsb = (const u16*)(p->ws + OFF_W) + W_SGU;
  const int tid = tid_(), lane = tid & 63, wave = tid >> 6, l15 = lane & 15, quad = lane >> 4;
  const int wr = wave >> 1, wc = wave & 1;
  const size_t t0 = (size_t)item * 128;
  __syncthreads();
  {
    const int tok = tid >> 1, half = tid & 1;
    const u16* vr = P + F_VA + (t0 + tok) * 512 + half * 256;
    float sum = 0.f, sq = 0.f;
    for (int i = 0; i < 32; ++i) {
      float f[8]; unpack8(*(const bf16x8*)(vr + i * 8), f);
#pragma unroll
      for (int e = 0; e < 8; ++e) { sum += f[e]; sq += f[e] * f[e]; }
    }
    sum += dpp_xor1(sum); sq += dpp_xor1(sq);
    const float mu = sum * (1.f / 512.f);
    const float var = fmaxf(sq * (1.f / 512.f) - mu * mu, 0.f);
    if (half == 0) { stats[tok * 2] = mu; stats[tok * 2 + 1] = rsqrtf(var + 1e-5f); }
  }
  __syncthreads();
  for (int g = 0; g < 4; ++g) {
    {
      const int q = tid & 127, hf = tid >> 7;
      const float mu = stats[q * 2], rs = stats[q * 2 + 1];
      const u16* vr = P + F_VA + (t0 + q) * 512 + g * 128 + hf * 64;
      const float* lg = p->sgu_ln_g + l * 512 + g * 128 + hf * 64;
      const float* lb = p->sgu_ln_b + l * 512 + g * 128 + hf * 64;
      for (int i = 0; i < 8; ++i) {
        float f[8]; unpack8(*(const bf16x8*)(vr + i * 8), f);
#pragma unroll
        for (int e = 0; e < 8; ++e) VnT[(hf * 64 + i * 8 + e) * 136 + q] = f2bf((f[e] - mu) * rs * lg[i * 8 + e] + lb[i * 8 + e]);
      }
    }
    __syncthreads();
    f32x4 acc[4][4]; zero_acc<4>(acc);
#pragma unroll
    for (int ks = 0; ks < 4; ++ks) {
      bf16x8 a[4], bb[4];
#pragma unroll
      for (int m = 0; m < 4; ++m) a[m] = *(const bf16x8*)(Wsb + (size_t)g * 16384 + (wr * 64 + m * 16 + l15) * 128 + ks * 32 + quad * 8);
#pragma unroll
      for (int n = 0; n < 4; ++n) bb[n] = *(const bf16x8*)(VnT + (wc * 64 + n * 16 + l15) * 136 + ks * 32 + quad * 8);
#pragma unroll
      for (int m = 0; m < 4; ++m)
#pragma unroll
        for (int n = 0; n < 4; ++n) acc[m][n] = mfma16(a[m], bb[n], acc[m][n]);
    }
    const float* bias = p->sgu_b + l * 512 + g * 128;
    u16* ua = P + F_UA + t0 * 512 + g * 128;
    {
      u16* Cs = (u16*)(smem + 128 * 136 * 2 + 1024);
      epi_foreach<4>(acc, [&](int r, int c, float v) { Cs[r * 136 + c] = f2bf(v + bias[r]); });
      __syncthreads();
#pragma unroll 2
      for (int i = 0; i < 8; ++i) {
        const int c = tid + i * 256, row = c >> 4, cc = (c & 15) * 8;
        u16* e = ua + (size_t)row * 512 + cc;
        float fu[8], fs[8];
        unpack8(*(const bf16x8*)e, fu); unpack8(*(const bf16x8*)(Cs + row * 136 + cc), fs);
#pragma unroll
        for (int k = 0; k < 8; ++k) fu[k] *= fs[k];
        *(bf16x8*)e = pack8(fu);
      }
    }
    __syncthreads();
  }
}

template <int RS>
DEV void scan_item(PPtr p, int l, int item, bool lat, unsigned char* smem) {
  float* sR = (float*)smem;
  float* sK = sR + 2048; float* sV = sK + 2048; float* sW = sV + 2048; float* sA = sW + 2048; float* sB = sA + 2048;
  float* sY = sB + 2048;
  u16* XW = (u16*)(sY + 2048);
  u16* XA = XW + 32 * 72;
  const u16* P = (const u16*)(p->ws + OFF_P);
  const u16* Wb = (const u16*)(p->ws + OFF_W);
  u16* Y = (u16*)(p->ws + OFF_Y);
  float* COEF = (float*)(p->ws + OFF_COEF);
  const int tid = tid_(), lane = tid & 63, wave = tid >> 6, l15 = lane & 15, quad = lane >> 4;
  constexpr int LPR = 4 * RS, KPL = 16 / RS, ROWS = 64 / RS, NV4 = KPL / 4, KP2 = KPL / 2;
  if (lat) __builtin_amdgcn_s_setprio(3);
  const int rpart = item % RS, sci = item / RS;
  const int b = sci >> 4, h = (sci >> 1) & 7, d = sci & 1;
  const int L = lat ? 2048 : 256;
  const size_t tbase = lat ? TCTX + (size_t)b * 2048 : (size_t)b * 256;
  const int v = rpart * ROWS + tid / LPR, kq = tid % LPR, key0 = kq * KPL;
  f32x2 S2[KP2];
  if (lat) {
    const float* s0 = p->state_wkv + ((((size_t)(b * 2 + l) * 2 + d) * 8 + h) * 64 + v) * 64 + key0;
#pragma unroll
    for (int i = 0; i < NV4; ++i) { float4 t4 = *(const float4*)(s0 + i * 4); S2[2 * i] = (f32x2){t4.x, t4.y}; S2[2 * i + 1] = (f32x2){t4.z, t4.w}; }
  } else {
#pragma unroll
    for (int i = 0; i < KP2; ++i) S2[i] = (f32x2){0.f, 0.f};
  }
  const float* mu = p->rwkv_mu + (size_t)(l * 2 + d) * 1664;
  const int sl = tid >> 3, part = tid & 7, ch0 = part * 8;
  float* sC = (float*)(XA + 32 * 72);
  __syncthreads();
  if (tid < 64) {
    sC[tid] = mu[h * 64 + tid]; sC[64 + tid] = mu[512 + h * 64 + tid]; sC[128 + tid] = mu[1024 + h * 64 + tid];
    sC[192 + tid] = mu[1536 + tid]; sC[256 + tid] = mu[1600 + tid];
    sC[320 + tid] = p->rwkv_k_k[l * 512 + h * 64 + tid]; sC[384 + tid] = p->rwkv_k_a[l * 512 + h * 64 + tid]; sC[448 + tid] = p->rwkv_r_k[l * 512 + h * 64 + tid];
  }
  __syncthreads();
  const int lm = wave & 1, ln0 = (wave >> 1) * 2;
  const u16* w2T = Wb + W_W2 + (size_t)d * 512 * 64 + (size_t)(h * 64) * 64;
  const u16* a2T = Wb + W_A2 + (size_t)d * 512 * 64 + (size_t)(h * 64) * 64;
  const float* w0 = p->rwkv_w0 + (size_t)(l * 2 + d) * 512 + h * 64;
  const float* a0 = p->rwkv_a0 + (size_t)(l * 2 + d) * 512 + h * 64;
  const int nch = L >> 5;
  bf16x8 q_r, q_k, q_v, q_w, q_a, n_r, n_k, n_v, n_w, n_a;
#define SCAN_FETCH(cc)                                                                                   \
  {                                                                                                      \
    const int s_ = (cc) * 32 + sl;                                                                       \
    const size_t t_ = tbase + (d ? (L - 1 - s_) : s_);                                                   \
    const size_t tn_ = (s_ > 0) ? (d ? t_ + 1 : t_ - 1) : t_;                                            \
    q_r = *(const bf16x8*)(P + F_RKV + t_ * 1536 + h * 64 + ch0);                                        \
    q_k = *(const bf16x8*)(P + F_RKV + t_ * 1536 + 512 + h * 64 + ch0);                                  \
    q_v = *(const bf16x8*)(P + F_RKV + t_ * 1536 + 1024 + h * 64 + ch0);                                 \
    q_w = *(const bf16x8*)(P + F_LORA + t_ * 256 + d * 128 + ch0);                                       \
    q_a = *(const bf16x8*)(P + F_LORA + t_ * 256 + d * 128 + 64 + ch0);                                  \
    n_r = *(const bf16x8*)(P + F_RKV + tn_ * 1536 + h * 64 + ch0);                                       \
    n_k = *(const bf16x8*)(P + F_RKV + tn_ * 1536 + 512 + h * 64 + ch0);                                 \
    n_v = *(const bf16x8*)(P + F_RKV + tn_ * 1536 + 1024 + h * 64 + ch0);                                \
    n_w = *(const bf16x8*)(P + F_LORA + tn_ * 256 + d * 128 + ch0);                                      \
    n_a = *(const bf16x8*)(P + F_LORA + tn_ * 256 + d * 128 + 64 + ch0);                                 \
  }
  SCAN_FETCH(0)
  bf16x8 bwf[2][2], baf[2][2];
#pragma unroll
  for (int ks = 0; ks < 2; ++ks)
#pragma unroll
    for (int n = 0; n < 2; ++n) {
      bwf[ks][n] = *(const bf16x8*)(w2T + (size_t)((ln0 + n) * 16 + l15) * 64 + ks * 32 + quad * 8);
      baf[ks][n] = *(const bf16x8*)(a2T + (size_t)((ln0 + n) * 16 + l15) * 64 + ks * 32 + quad * 8);
    }
  for (int c = 0; c < nch; ++c) {
    const int s = c * 32 + sl;
    const int pos = d ? (L - 1 - s) : s;
    const size_t t = tbase + pos;
    const bool hasnb = s > 0;
    float fr[8], fk[8], fv[8], fw[8], fa[8];
    {
      unpack8(q_r, fr); unpack8(q_k, fk); unpack8(q_v, fv); unpack8(q_w, fw); unpack8(q_a, fa);
      float nr[8], nk[8], nv[8], nw[8], na[8];
      unpack8(n_r, nr); unpack8(n_k, nk); unpack8(n_v, nv); unpack8(n_w, nw); unpack8(n_a, na);
      if (!hasnb) {
#pragma unroll
        for (int i = 0; i < 8; ++i) { nr[i] = 0.f; nk[i] = 0.f; nv[i] = 0.f; nw[i] = 0.f; na[i] = 0.f; }
      }
#pragma unroll
      for (int i = 0; i < 8; ++i) {
        fr[i] += sC[ch0 + i] * (nr[i] - fr[i]); fk[i] += sC[64 + ch0 + i] * (nk[i] - fk[i]); fv[i] += sC[128 + ch0 + i] * (nv[i] - fv[i]);
        fw[i] += sC[192 + ch0 + i] * (nw[i] - fw[i]); fa[i] += sC[256 + ch0 + i] * (na[i] - fa[i]);
      }
    }
    if (c + 1 < nch) SCAN_FETCH(c + 1)
    {
      float tw[8];
#pragma unroll
      for (int i = 0; i < 8; ++i) tw[i] = 1.f - 2.f * frcp(__expf(2.f * fw[i]) + 1.f);
      *(bf16x8*)(XW + sl * 72 + ch0) = pack8(tw);
      *(bf16x8*)(XA + sl * 72 + ch0) = pack8(fa);
#pragma unroll
      for (int i = 0; i < 2; ++i) {
        *(float4*)(sR + sl * 64 + ch0 + i * 4) = make_float4(fr[i * 4], fr[i * 4 + 1], fr[i * 4 + 2], fr[i * 4 + 3]);
        *(float4*)(sV + sl * 64 + ch0 + i * 4) = make_float4(fv[i * 4], fv[i * 4 + 1], fv[i * 4 + 2], fv[i * 4 + 3]);
      }
    }
    __syncthreads();
    {
      f32x4 aw[2], aa[2];
#pragma unroll
      for (int n = 0; n < 2; ++n) { aw[n] = (f32x4){0.f, 0.f, 0.f, 0.f}; aa[n] = (f32x4){0.f, 0.f, 0.f, 0.f}; }
#pragma unroll
      for (int ks = 0; ks < 2; ++ks) {
        bf16x8 xw = *(const bf16x8*)(XW + (lm * 16 + l15) * 72 + ks * 32 + quad * 8);
        bf16x8 xa = *(const bf16x8*)(XA + (lm * 16 + l15) * 72 + ks * 32 + quad * 8);
#pragma unroll
        for (int n = 0; n < 2; ++n) {
          aw[n] = mfma16(xw, bwf[ks][n], aw[n]);
          aa[n] = mfma16(xa, baf[ks][n], aa[n]);
        }
      }
#pragma unroll
      for (int n = 0; n < 2; ++n) {
        const int ch = (ln0 + n) * 16 + l15;
        const float w0c = w0[ch], a0c = a0[ch];
#pragma unroll
        for (int j = 0; j < 4; ++j) {
          const int row = lm * 16 + quad * 4 + j;
          const float z = w0c + aw[n][j];
          sW[row * 64 + ch] = __expf(-0.60653065971263342f * sigmoidf_(z));
          sA[row * 64 + ch] = sigmoidf_(a0c + aa[n][j]);
        }
      }
    }
    __syncthreads();
    {
      float av[8], kk[8], ssq = 0.f, cf = 0.f;
      {
        const float4 a0 = *(const float4*)(sA + sl * 64 + ch0), a1 = *(const float4*)(sA + sl * 64 + ch0 + 4);
        av[0] = a0.x; av[1] = a0.y; av[2] = a0.z; av[3] = a0.w; av[4] = a1.x; av[5] = a1.y; av[6] = a1.z; av[7] = a1.w;
      }
#pragma unroll
      for (int i = 0; i < 8; ++i) { kk[i] = fk[i] * sC[320 + ch0 + i]; ssq += kk[i] * kk[i]; }
      ssq += dpp_xor1(ssq); ssq += dpp_xor2(ssq); ssq += dpp_hmirror(ssq);
      const float inv = rsqrtf(fmaxf(ssq, 1e-24f));
      float kmv[8], knv[8], kbv[8];
#pragma unroll
      for (int i = 0; i < 8; ++i) {
        const float kn = kk[i] * inv;
        const float km = fk[i] * (1.f + (av[i] - 1.f) * sC[384 + ch0 + i]);
        cf += fr[i] * km * sC[448 + ch0 + i];
        kmv[i] = km; knv[i] = -kn; kbv[i] = kn * av[i];
      }
#pragma unroll
      for (int i = 0; i < 2; ++i) {
        *(float4*)(sK + sl * 64 + ch0 + i * 4) = make_float4(kmv[i * 4], kmv[i * 4 + 1], kmv[i * 4 + 2], kmv[i * 4 + 3]);
        *(float4*)(sA + sl * 64 + ch0 + i * 4) = make_float4(knv[i * 4], knv[i * 4 + 1], knv[i * 4 + 2], knv[i * 4 + 3]);
        *(float4*)(sB + sl * 64 + ch0 + i * 4) = make_float4(kbv[i * 4], kbv[i * 4 + 1], kbv[i * 4 + 2], kbv[i * 4 + 3]);
      }
      cf += dpp_xor1(cf); cf += dpp_xor2(cf); cf += dpp_hmirror(cf);
      if (part == 0 && rpart == 0) COEF[(t * 8 + h) * 2 + d] = cf;
    }
    __syncthreads();
    {
      f32x2 wA[KP2], kA[KP2], aA[KP2], bA[KP2], rA[KP2]; float vA;
#define SCAN_LD(X_, arr_, st_)                                                                                   \
  _Pragma("unroll") for (int i = 0; i < NV4; ++i) {                                                              \
    const float4 t4 = *(const float4*)((arr_) + (st_) * 64 + key0 + i * 4);                                      \
    X_[2 * i] = (f32x2){t4.x, t4.y}; X_[2 * i + 1] = (f32x2){t4.z, t4.w};                                        \
  }
      SCAN_LD(aA, sA, 0) SCAN_LD(kA, sK, 0) SCAN_LD(bA, sB, 0) SCAN_LD(wA, sW, 0) SCAN_LD(rA, sR, 0)
      vA = sV[v];
      constexpr bool DEFER = (RS >= 2);
      float yp[DEFER ? 32 : 1];
#pragma unroll(DEFER ? 32 : 2)
      for (int st = 0; st < 32; ++st) {
        const int sn = (st + 1) & 31;
        f32x2 sacc = S2[0] * aA[0];
#pragma unroll
        for (int i = 1; i < KP2; ++i) sacc = __builtin_elementwise_fma(S2[i], aA[i], sacc);
        SCAN_LD(aA, sA, sn)
        const f32x2 vv = {vA, vA};
        f32x2 vk[KP2];
#pragma unroll
        for (int i = 0; i < KP2; ++i) vk[i] = vv * kA[i];
        SCAN_LD(kA, sK, sn)
        vA = sV[sn * 64 + v];
        float sa = sacc.x + sacc.y;
        sa += dpp_xor1(sa); sa += dpp_xor2(sa);
        if (LPR >= 8) sa += dpp_hmirror(sa);
        if (LPR >= 16) sa += dpp_mirror(sa);
        const f32x2 sav = {sa, sa};
#pragma unroll
        for (int i = 0; i < KP2; ++i) vk[i] = __builtin_elementwise_fma(sav, bA[i], vk[i]);
        SCAN_LD(bA, sB, sn)
#pragma unroll
        for (int i = 0; i < KP2; ++i) S2[i] = __builtin_elementwise_fma(S2[i], wA[i], vk[i]);
        SCAN_LD(wA, sW, sn)
        f32x2 yacc = S2[0] * rA[0];
#pragma unroll
        for (int i = 1; i < KP2; ++i) yacc = __builtin_elementwise_fma(S2[i], rA[i], yacc);
        SCAN_LD(rA, sR, sn)
        if (DEFER) yp[DEFER ? st : 0] = yacc.x + yacc.y;
        else {
          float y = yacc.x + yacc.y;
          y += dpp_xor1(y); y += dpp_xor2(y);
          if (LPR >= 8) y += dpp_hmirror(y);
          if (LPR >= 16) y += dpp_mirror(y);
          sY[st * 64 + v] = y;
        }
      }
      if (DEFER) {
#pragma unroll
      for (int st = 0; st < 32; ++st) yp[st] += dpp_xor1(yp[st]);
#pragma unroll
      for (int st = 0; st < 32; ++st) yp[st] += dpp_xor2(yp[st]);
      if (LPR >= 8) {
#pragma unroll
        for (int st = 0; st < 32; ++st) yp[st] += dpp_hmirror(yp[st]);
      }
      if (LPR >= 16) {
#pragma unroll
        for (int st = 0; st < 32; ++st) yp[st] += dpp_mirror(yp[st]);
      }
#pragma unroll
      for (int st = 0; st < 32; ++st) sY[st * 64 + v] = yp[st];
      }
#undef SCAN_LD
    }
    __syncthreads();
    {
      float yv[8];
#pragma unroll
      for (int i = 0; i < 8; ++i) yv[i] = sY[sl * 64 + ch0 + i];
      if (ch0 >= rpart * ROWS && ch0 < (rpart + 1) * ROWS) *(bf16x8*)(Y + (size_t)d * TT * 512 + t * 512 + h * 64 + ch0) = pack8(yv);
    }
#undef SCAN_FETCH_DUMMY
  }
  __builtin_amdgcn_s_setprio(0);
  if (!lat) {
    float* dst = p->out + O_NST + ((((size_t)(b * 2 + l) * 2 + d) * 8 + h) * 64 + v) * 64 + key0;
#pragma unroll
    for (int i = 0; i < NV4; ++i) *(float4*)(dst + i * 4) = make_float4(S2[2 * i].x, S2[2 * i].y, S2[2 * i + 1].x, S2[2 * i + 1].y);
  }
  __syncthreads();
}

constexpr int SCAN_RS = 2;
constexpr int SCAN_RS_CTX = 1;
constexpr int MIX_LS = 128 * SCAN_RS, MIX_CS = 512 * SCAN_RS_CTX, MIX_LA = 1024, MIX_SG = 192, MIX_CA = 512;
constexpr int MIX_B = MIX_LA + MIX_CS + MIX_SG + MIX_CA;
constexpr size_t OFF_CUTAB = 458752;

DEV void phase_mix(PPtr p, int l, unsigned char* smem) {
  unsigned* ctrA = (unsigned*)(p->ws + OFF_CTR) + l * 2;
  unsigned* ctrB = ctrA + 1;
  int* slot = (int*)(smem + SMEM_BYTES - 16);
  const int tidm = tid_();
  __syncthreads();
  if (tidm == 0) {
    const unsigned hw = __builtin_amdgcn_s_getreg((31 << 11) | 4), xcc = __builtin_amdgcn_s_getreg((3 << 11) | 20);
    const unsigned key = ((xcc & 15u) << 8) | ((hw >> 8) & 255u);
    slot[1] = (int)atomicAdd((unsigned*)(p->ws + OFF_CUTAB) + l * 4096 + key, 1u);
  }
  __syncthreads();
  const bool primary = slot[1] == 0;
  bool a_open = true, b_open = true;
  for (;;) {
    __syncthreads();
    if (tidm == 0) {
      int it = -1;
      if (primary) {
        if (a_open) { it = (int)atomicAdd(ctrA, 1u); if (it >= MIX_LS) { a_open = false; it = -1; } }
        if (it < 0 && b_open) { it = (int)atomicAdd(ctrB, 1u); if (it >= MIX_B) { b_open = false; it = -1; } else it += MIX_LS; }
      } else {
        if (b_open) { it = (int)atomicAdd(ctrB, 1u); if (it >= MIX_B) { b_open = false; it = -1; } else it += MIX_LS; }
        if (it < 0 && a_open) { it = (int)atomicAdd(ctrA, 1u); if (it >= MIX_LS) { a_open = false; it = -1; } }
      }
      *slot = it;
    }
    __syncthreads();
    int item = *slot;
    if (item < 0) break;
    if (item < MIX_LS) scan_item<SCAN_RS>(p, l, item, true, smem);
    else if ((item -= MIX_LS) < MIX_LA) attn_item(p, item, true, smem);
    else if ((item -= MIX_LA) < MIX_CS) scan_item<SCAN_RS_CTX>(p, l, item, false, smem);
    else if ((item -= MIX_CS) < MIX_SG) sgu_item(p, l, item, smem);
    else attn_item(p, item - MIX_SG, false, smem);
  }
}

DEV void phase_fin(PPtr p, int l, unsigned char* smem) {
  u16* As = (u16*)smem; u16* Bs = As + 128 * 72; u16* Zs = Bs + 128 * 72;
  const u16* P = (const u16*)(p->ws + OFF_P);
  const u16* W = (const u16*)(p->ws + OFF_W);
  u16* Y = (u16*)(p->ws + OFF_Y);
  const float* COEF = (const float*)(p->ws + OFF_COEF);
  const int tid = tid_();
  for (int id = vblock(); id < 384 * 4; id += gridDim.x) {
    int mt, nt; tile_map(id, 4, mt, nt);
    const int m0 = mt * 64, c0 = nt * 128;
    __syncthreads();
    for (int it = 0; it < 4; ++it) {
      const int slot = it * 256 + tid, pair = slot >> 3, sub = slot & 7;
      const int tok = pair >> 1, hd = pair & 1;
      const int ch = c0 + hd * 64 + sub * 8, head = nt * 2 + hd;
      const size_t t = (size_t)m0 + tok;
      const bool lat = t >= TCTX;
      const int pos = lat ? (int)((t - TCTX) & 2047) : (int)(t & 255);
      const int L = lat ? 2048 : 256;
      float y0[8], y1[8];
      unpack8(*(const bf16x8*)(Y + t * 512 + ch), y0);
      unpack8(*(const bf16x8*)(Y + (size_t)TT * 512 + t * 512 + ch), y1);
      float sum = 0.f;
#pragma unroll
      for (int i = 0; i < 8; ++i) { y0[i] += y1[i]; sum += y0[i]; }
      sum += dpp_xor1(sum); sum += dpp_xor2(sum); sum += dpp_hmirror(sum);
      const float mu = sum * (1.f / 64.f);
      float sq = 0.f;
#pragma unroll
      for (int i = 0; i < 8; ++i) { y0[i] -= mu; sq += y0[i] * y0[i]; }
      sq += dpp_xor1(sq); sq += dpp_xor2(sq); sq += dpp_hmirror(sq);
      const float rs = rsqrtf(sq * (1.f / 64.f) + GN_EPS);
      float vv[8], n0v[8], n1v[8];
      unpack8(*(const bf16x8*)(P + F_RKV + t * 1536 + 1024 + ch), vv);
      if (pos > 0) unpack8(*(const bf16x8*)(P + F_RKV + (t - 1) * 1536 + 1024 + ch), n0v);
      else {
#pragma unroll
        for (int i = 0; i < 8; ++i) n0v[i] = 0.f;
      }
      if (pos < L - 1) unpack8(*(const bf16x8*)(P + F_RKV + (t + 1) * 1536 + 1024 + ch), n1v);
      else {
#pragma unroll
        for (int i = 0; i < 8; ++i) n1v[i] = 0.f;
      }
      const float cf0 = COEF[(t * 8 + head) * 2], cf1 = COEF[(t * 8 + head) * 2 + 1];
      const float* mu0 = p->rwkv_mu + (size_t)(l * 2) * 1664 + 1024 + ch;
      const float* mu1 = p->rwkv_mu + (size_t)(l * 2 + 1) * 1664 + 1024 + ch;
      const float* lg = p->rwkv_lnx_g + l * 512 + ch;
      const float* lb = p->rwkv_lnx_b + l * 512 + ch;
      float z[8];
#pragma unroll
      for (int i = 0; i < 8; ++i) {
        const float vs0 = vv[i] + mu0[i] * (n0v[i] - vv[i]);
        const float vs1 = vv[i] + mu1[i] * (n1v[i] - vv[i]);
        z[i] = y0[i] * rs * lg[i] + lb[i] + cf0 * vs0 + cf1 * vs1;
      }
      *(bf16x8*)(Zs + tok * 136 + hd * 64 + sub * 8) = pack8(z);
    }
    ASig al{P + F_GD + (size_t)m0 * 128, 128};
    f32x4 acc[2][4]; zero_acc<2>(acc);
    gemm_mainloop<2>(acc, al, W + W_G2 + (size_t)c0 * 128, 128, 128, As, Bs);
    u16* dst = Y + (size_t)m0 * 512 + c0;
    epi_bf16<2>(acc, As, dst, 512, [&](int r, int c, float v) { return v * bf2f(Zs[r * 136 + c]); });
    {
      const float* xr0 = (l == 0) ? (m0 < TCTX ? p->x_prompt + (size_t)m0 * 1024 : p->x_sample + (size_t)(m0 - TCTX) * 1024) : p->out + (size_t)m0 * 1024;
      const float* mod = (const float*)(p->ws + OFF_MOD) + (size_t)(l * 9 + cv_of(m0)) * 6144;
      u16* Pw = (u16*)(p->ws + OFF_P);
#pragma unroll 4
      for (int i = 0; i < 8; ++i) {
        const int c = tid + i * 256, row = c >> 5, cc = c & 31;
        const int hcol = (cc < 16) ? c0 + cc * 8 : 512 + c0 + (cc - 16) * 8;
        bf16x8 hv;
        if (l == 0) { AModX al{xr0, mod + 1024, mod}; hv = al(row, hcol); }
        else {
          const float2 ms = *(const float2*)((const float*)(p->ws + OFF_ST) + (size_t)TT * 2 + ((size_t)m0 + row) * 2);
          const float* xr = xr0 + (size_t)row * 1024 + hcol;
          const float* lg = p->ln2_g + hcol; const float* lb = p->ln2_b + hcol;
          float f[8];
#pragma unroll
          for (int e = 0; e < 8; ++e) {
            const float xv = (xr[e] - ms.x) * ms.y * lg[e] + lb[e];
            f[e] = xv * (1.f + mod[1024 + hcol + e]) + mod[hcol + e];
          }
          hv = pack8(f);
        }
        u16* d = (cc < 16) ? Pw + F_VA + ((size_t)m0 + row) * 512 + c0 + cc * 8 : Y + (size_t)TT * 512 + ((size_t)m0 + row) * 512 + c0 + (cc - 16) * 8;
        *(bf16x8*)d = hv;
      }
    }
  }
}

DEV void phase_merge1(PPtr p, int l, unsigned char* smem) {
  u16* Ct = (u16*)(smem + 32768);
  u16* P = (u16*)(p->ws + OFF_P);
  const u16* W = (const u16*)(p->ws + OFF_W);
  const u16* Y = (const u16*)(p->ws + OFF_Y);
  const u16* HLO = P + F_VA;
  const u16* HHI = Y + (size_t)TT * 512;
  u16* MIX = P + F_RKV;
  TQ tq{(unsigned*)(p->ws + OFF_GQ) + (l * 5 + 1) * 128, 192 * 8, xcc_id(), 0};
  int* slot = (int*)(smem + SMEM_BYTES - 16);
  const int tidq = tid_();
  bool pre = false;
  int id = tq_pull(tq, slot, tidq);
  while (id >= 0) {
    int mt, nt; tile_map(id, 8, mt, nt);
    const int m0 = mt * 128, n0 = nt * 128;
    const int idn = tq_pull(tq, slot, tidq); const bool hn = idn >= 0;
    int mtn = 0, ntn = 0; if (hn) tile_map(idn, 8, mtn, ntn);
    f32x4 mix[4][4]; zero_acc<4>(mix);
#pragma unroll 1
    for (int j = 0; j < 3; ++j) {
      const u16* br = ((j == 0) ? P + F_UA : (j == 1) ? P + F_Q : Y) + (size_t)m0 * 512;
      const u16* wb = W + W_BR + ((size_t)j * 1024 + n0) * 512;
      unsigned sg[4][4][2];
      {
        f32x4 accG[4][4]; zero_acc<4>(accG);
        const u16* wg = W + W_IN + ((size_t)3712 + j * 1024 + n0) * 1024;
        gemm_mainloop_dma<4>(accG, HLO + (size_t)m0 * 512, 512, wg, 1024, 512, smem, pre || j > 0, HHI + (size_t)m0 * 512, 512, wg + 512, 1024);
        gemm_mainloop_dma<4>(accG, HHI + (size_t)m0 * 512, 512, wg + 512, 1024, 512, smem, true, br, 512, wb, 512);
#pragma unroll
        for (int m = 0; m < 4; ++m)
#pragma unroll
          for (int n = 0; n < 4; ++n) {
            sg[m][n][0] = pk2(sigmoidf_(accG[m][n][0]), sigmoidf_(accG[m][n][1]));
            sg[m][n][1] = pk2(sigmoidf_(accG[m][n][2]), sigmoidf_(accG[m][n][3]));
          }
      }
      const u16* nA; const u16* nB;
      if (j < 2) { nA = HLO + (size_t)m0 * 512; nB = W + W_IN + ((size_t)3712 + (j + 1) * 1024 + n0) * 1024; }
      else { nA = hn ? HLO + (size_t)mtn * 128 * 512 : nullptr; nB = W + W_IN + ((size_t)3712 + ntn * 128) * 1024; }
      f32x4 accP[4][4]; zero_acc<4>(accP);
      gemm_mainloop_dma<4, false>(accP, br, 512, wb, 512, 512, smem, true, nA, 512, nB, 1024);
#pragma unroll
      for (int m = 0; m < 4; ++m)
#pragma unroll
        for (int n = 0; n < 4; ++n) {
          mix[m][n][0] += __uint_as_float(sg[m][n][0] << 16) * accP[m][n][0];
          mix[m][n][1] += __uint_as_float(sg[m][n][0] & 0xffff0000u) * accP[m][n][1];
          mix[m][n][2] += __uint_as_float(sg[m][n][1] << 16) * accP[m][n][2];
          mix[m][n][3] += __uint_as_float(sg[m][n][1] & 0xffff0000u) * accP[m][n][3];
        }
    }
    pre = hn;
    u16* dst = MIX + (size_t)m0 * 1024 + n0;
    epi_bf16<4>(mix, Ct, dst, 1024, [](int, int, float v) { return v; });
    id = idn;
  }
}

DEV void phase_merge2(PPtr p, int l, unsigned char* smem) {
  const u16* P = (const u16*)(p->ws + OFF_P);
  const u16* W = (const u16*)(p->ws + OFF_W);
  const float* MOD = (const float*)(p->ws + OFF_MOD);
  const u16* MIX = P + F_RKV;
  TQ tq{(unsigned*)(p->ws + OFF_GQ) + (l * 5 + 2) * 128, 192 * 8, xcc_id(), 0};
  int* slot = (int*)(smem + SMEM_BYTES - 16);
  const int tidq = tid_();
  bool pre = false;
  int id = tq_pull(tq, slot, tidq);
  while (id >= 0) {
    int mt, nt; tile_map(id, 8, mt, nt);
    const int m0 = mt * 128, n0 = nt * 128;
    const int idn = tq_pull(tq, slot, tidq); const bool hn = idn >= 0;
    int mtn = 0, ntn = 0; if (hn) tile_map(idn, 8, mtn, ntn);
    const float* xrow0 = (l == 0) ? (m0 < TCTX ? p->x_prompt + (size_t)m0 * 1024 : p->x_sample + (size_t)(m0 - TCTX) * 1024) : p->out + (size_t)m0 * 1024;
    const float* g1 = MOD + (size_t)(l * 9 + cv_of(m0)) * 6144 + 2048 + n0;
    f32x4 acc[4][4]; zero_acc<4>(acc);
    gemm_mainloop_dma<4>(acc, MIX + (size_t)m0 * 1024, 1024, W + W_OUT + (size_t)n0 * 1024, 1024, 1024, smem, pre,
                         hn ? MIX + (size_t)mtn * 128 * 1024 : nullptr, 1024, W + W_OUT + (size_t)ntn * 128 * 1024, 1024);
    pre = hn;
    float* dst = p->out + (size_t)m0 * 1024 + n0;
    const float* xs = xrow0 + n0;
    const float* st2 = (const float*)(p->ws + OFF_ST) + (size_t)TT * 2 + (size_t)m0 * 2;
    const float* lng = p->ln2_g + n0; const float* lnb = p->ln2_b + n0;
    epi_f32(acc, (float*)(smem + 32768), [&](int r, int c, float4 a) {
      float4 x4 = *(const float4*)(xs + (size_t)r * 1024 + c);
      const float4 g4 = *(const float4*)(g1 + c);
      if (l == 1) {
        const float2 ms = *(const float2*)(st2 + r * 2);
        const float4 lg = *(const float4*)(lng + c), lb = *(const float4*)(lnb + c);
        x4 = make_float4((x4.x - ms.x) * ms.y * lg.x + lb.x, (x4.y - ms.x) * ms.y * lg.y + lb.y, (x4.z - ms.x) * ms.y * lg.z + lb.z, (x4.w - ms.x) * ms.y * lg.w + lb.w);
      }
      *(float4*)(dst + (size_t)r * 1024 + c) = make_float4(ALPHA * x4.x + g4.x * a.x, ALPHA * x4.y + g4.y * a.y, ALPHA * x4.z + g4.z * a.z, ALPHA * x4.w + g4.w * a.w);
    });
    id = idn;
  }
}

DEV void phase_ln(PPtr p, const float* g, const float* bta, const float* modl, int sc_off, int sh_off, float* stats) {
  const int tid = tid_(); const int lane = tid & 63, wave = tid >> 6;
  float4 nv[4];
  {
    const float* r0 = p->out + (size_t)(blockIdx.x * 4 + wave) * 1024;
#pragma unroll
    for (int i = 0; i < 4; ++i) nv[i] = *(const float4*)(r0 + (i * 64 + lane) * 4);
  }
  for (int u = blockIdx.x; u < TT / 4; u += gridDim.x) {
    float* row = p->out + (size_t)(u * 4 + wave) * 1024;
    float4 v[4];
    float sum = 0.f;
#pragma unroll
    for (int i = 0; i < 4; ++i) { v[i] = nv[i]; sum += v[i].x + v[i].y + v[i].z + v[i].w; }
    if (u + (int)gridDim.x < TT / 4) {
      const float* rn = row + (size_t)gridDim.x * 4 * 1024;
#pragma unroll
      for (int i = 0; i < 4; ++i) nv[i] = *(const float4*)(rn + (i * 64 + lane) * 4);
    }
    sum = wave_sum(sum, lane);
    const float mu = sum * (1.f / 1024.f);
    float sq = 0.f;
#pragma unroll
    for (int i = 0; i < 4; ++i) {
      v[i].x -= mu; v[i].y -= mu; v[i].z -= mu; v[i].w -= mu;
      sq += v[i].x * v[i].x + v[i].y * v[i].y + v[i].z * v[i].z + v[i].w * v[i].w;
    }
    sq = wave_sum(sq, lane);
    const float rs = rsqrtf(sq * (1.f / 1024.f) + 1e-5f);
    if (stats && lane == 0) *(float2*)(stats + (size_t)(u * 4 + wave) * 2) = make_float2(mu, rs);
#pragma unroll
    for (int i = 0; i < 4; ++i) {
      const int c = (i * 64 + lane) * 4;
      float4 gg = *(const float4*)(g + c), bb = *(const float4*)(bta + c);
      float4 o4 = make_float4(v[i].x * rs * gg.x + bb.x, v[i].y * rs * gg.y + bb.y, v[i].z * rs * gg.z + bb.z, v[i].w * rs * gg.w + bb.w);
      if (!stats) *(float4*)(row + c) = o4;
      if (modl) {
        const float* mrow = modl + (size_t)cv_of(u * 4 + wave) * 6144;
        const float4 s4 = *(const float4*)(mrow + sc_off + c), h4 = *(const float4*)(mrow + sh_off + c);
        uint2 hv;
        hv.x = pk2(o4.x * (1.f + s4.x) + h4.x, o4.y * (1.f + s4.y) + h4.y);
        hv.y = pk2(o4.z * (1.f + s4.z) + h4.z, o4.w * (1.f + s4.w) + h4.w);
        *(uint2*)((u16*)(p->ws + OFF_H) + (size_t)(u * 4 + wave) * 1024 + c) = hv;
      }
    }
  }
}

DEV void phase_ffn1(PPtr p, int l, unsigned char* smem) {
  u16* Ct = (u16*)(smem + 32768);
  const u16* W = (const u16*)(p->ws + OFF_W);
  const u16* H = (const u16*)(p->ws + OFF_H);
  u16* HID = (u16*)(p->ws + OFF_HID);
  TQ tq{(unsigned*)(p->ws + OFF_GQ) + (l * 5 + 3) * 128, 192 * 32, xcc_id(), 0};
  int* slot = (int*)(smem + SMEM_BYTES - 16);
  const int tidq = tid_();
  bool pre = false;
  int id = tq_pull(tq, slot, tidq);
  while (id >= 0) {
    int mt, nt; tile_map(id, 32, mt, nt);
    const int m0 = mt * 128, n0 = nt * 128;
    const int idn = tq_pull(tq, slot, tidq); const bool hn = idn >= 0;
    int mtn = 0, ntn = 0; if (hn) tile_map(idn, 32, mtn, ntn);
    f32x4 acc[4][4]; zero_acc<4>(acc);
    gemm_mainloop_dma<4>(acc, H + (size_t)m0 * 1024, 1024, W + W_UP + (size_t)n0 * 1024, 1024, 1024, smem, pre,
                         hn ? H + (size_t)mtn * 128 * 1024 : nullptr, 1024, W + W_UP + (size_t)ntn * 128 * 1024, 1024);
    pre = hn;
    u16* dst = HID + (size_t)m0 * 4096 + n0;
    epi_bf16<4>(acc, Ct, dst, 4096, [](int, int, float v) { float q = fmaxf(v, 0.f); return q * q; });
    id = idn;
  }
}

DEV void phase_ffn2(PPtr p, int l, unsigned char* smem) {
  const u16* W = (const u16*)(p->ws + OFF_W);
  const float* MOD = (const float*)(p->ws + OFF_MOD);
  const u16* HID = (const u16*)(p->ws + OFF_HID);
  TQ tq{(unsigned*)(p->ws + OFF_GQ) + (l * 5 + 4) * 128, 192 * 8, xcc_id(), 0};
  int* slot = (int*)(smem + SMEM_BYTES - 16);
  const int tidq = tid_();
  bool pre = false;
  int id = tq_pull(tq, slot, tidq);
  while (id >= 0) {
    int mt, nt; tile_map(id, 8, mt, nt);
    const int m0 = mt * 128, n0 = nt * 128;
    const int idn = tq_pull(tq, slot, tidq); const bool hn = idn >= 0;
    int mtn = 0, ntn = 0; if (hn) tile_map(idn, 8, mtn, ntn);
    const float* g2 = MOD + (size_t)(l * 9 + cv_of(m0)) * 6144 + 5120 + n0;
    f32x4 acc[4][4]; zero_acc<4>(acc);
    gemm_mainloop_dma<4>(acc, HID + (size_t)m0 * 4096, 4096, W + W_DOWN + (size_t)n0 * 4096, 4096, 4096, smem, pre,
                         hn ? HID + (size_t)mtn * 128 * 4096 : nullptr, 4096, W + W_DOWN + (size_t)ntn * 128 * 4096, 4096);
    pre = hn;
    float* dst = p->out + (size_t)m0 * 1024 + n0;
    const float* st1 = (const float*)(p->ws + OFF_ST) + (size_t)m0 * 2;
    const float* lng = p->ln1_g + l * 1024 + n0; const float* lnb = p->ln1_b + l * 1024 + n0;
    epi_f32(acc, (float*)(smem + 32768), [&](int r, int c, float4 a) {
      float* e = dst + (size_t)r * 1024 + c;
      const float2 ms = *(const float2*)(st1 + r * 2);
      const float4 y4 = *(const float4*)e, g4 = *(const float4*)(g2 + c), lg = *(const float4*)(lng + c), lb = *(const float4*)(lnb + c);
      const float4 x4 = make_float4((y4.x - ms.x) * ms.y * lg.x + lb.x, (y4.y - ms.x) * ms.y * lg.y + lb.y, (y4.z - ms.x) * ms.y * lg.z + lb.z, (y4.w - ms.x) * ms.y * lg.w + lb.w);
      *(float4*)e = make_float4(ALPHA * x4.x + g4.x * a.x, ALPHA * x4.y + g4.y * a.y, ALPHA * x4.z + g4.z * a.z, ALPHA * x4.w + g4.w * a.w);
    });
    id = idn;
  }
}

__global__ void __launch_bounds__(NTHR, 2) fwd_megakernel(Params p_unused) {
  __shared__ __attribute__((aligned(16))) unsigned char smem[SMEM_BYTES];
  cg::grid_group grid = cg::this_grid();
  PPtr kp = (PPtr)__builtin_amdgcn_kernarg_segment_ptr();
#define p launder_p(kp)
  {
    unsigned* st0 = (unsigned*)(smem + SMEM_BYTES - 8);
    if (tid_() == 0) {
      st0[0] = 0u; st0[1] = 0u;
      const unsigned x = (unsigned)__builtin_amdgcn_s_getreg((3 << 11) | 20) & 0xFu;
      (void)xb_add((unsigned*)(p->ws + OFF_XB) + XB_XCNT(x), 1u);
    }
    __syncthreads();
  }
#define MODP ((const float*)(p->ws + OFF_MOD))
#pragma unroll 1
  for (int step = 0; step < 21; ++step) {
    const int l = (step - 1) / 10, ph = (step - 1) % 10;
    if (step == 0) {
      for (int u = blockIdx.x; u < 192; u += gridDim.x) mod_unit(p, u, (float*)smem);
      if (p->ws == nullptr) grid.sync();
    } else if (ph == 0) { if (l == 0) phase_convert(p, 0, smem); else continue; }
    else if (ph == 1) phase_inproj(p, l, smem);
    else if (ph == 2) phase_mix(p, l, smem);
    else if (ph == 3) phase_fin(p, l, smem);
    else if (ph == 4) phase_merge1(p, l, smem);
    else if (ph == 5) phase_merge2(p, l, smem);
    else if (ph == 6) phase_ln(p, p->ln1_g + l * 1024, p->ln1_b + l * 1024, MODP + (size_t)l * 9 * 6144, 4096, 3072, (float*)(p->ws + OFF_ST));
    else if (ph == 7) phase_ffn1(p, l, smem);
    else if (ph == 8) phase_ffn2(p, l, smem);
    else {
      phase_ln(p, p->ln2_g + l * 1024, p->ln2_b + l * 1024, l == 0 ? MODP + (size_t)9 * 6144 : nullptr, 1024, 0, l == 0 ? (float*)(p->ws + OFF_ST) + (size_t)TT * 2 : nullptr);
      if (l == 0) phase_convert(p, 1, smem); else break;
    }
    gbar((unsigned*)(p->ws + OFF_XB), smem);
  }
}
#undef MODP
#undef p

extern "C" void kernel_launch(void* const* d_in, const int* in_sizes, int n_in, void* d_out, int out_size, void* d_ws,
                              size_t ws_size, hipStream_t stream) {
  static int grid_blocks = 0;
  if (!grid_blocks) {
    if (n_in != 35 || ws_size < WS_END) { fprintf(stderr, "kernel_launch: bad n_in %d or ws %zu < %zu\n", n_in, ws_size, (size_t)WS_END); grid_blocks = -1; return; }
    int dev = 0, cus = 0, per_cu = 0;
    hipGetDevice(&dev);
    hipDeviceGetAttribute(&cus, hipDeviceAttributeMultiprocessorCount, dev);
    hipOccupancyMaxActiveBlocksPerMultiprocessor(&per_cu, fwd_megakernel, NTHR, 0);
    if (per_cu > 2) per_cu = 2;
    if (per_cu < 1) per_cu = 1;
    grid_blocks = cus * per_cu;
  }
  if (grid_blocks < 0) return;
  hipMemsetAsync((unsigned char*)d_ws + OFF_CUTAB, 0, 65536, stream);
  Params p{};
  const float** pp = (const float**)&p;
  for (int i = 0; i < 35; ++i) pp[i] = (const float*)d_in[i];
  p.out = (float*)d_out;
  p.ws = (unsigned char*)d_ws;
  void* args[] = {&p};
  hipError_t e = hipLaunchCooperativeKernel((void*)fwd_megakernel, dim3(grid_blocks), dim3(NTHR), args, 0, stream);
  if (e != hipSuccess) fprintf(stderr, "cooperative launch failed: %s (grid %d)\n", hipGetErrorString(e), grid_blocks);
}
```
